# Optimizing an MI355X kernel written in HIP

```python
import math
import jax, jax.numpy as jnp
from jax import lax
import numpy as np

D_MODEL = 1024
BATCH = 8
SEQ = 8192
DEPTH = 1

N_META = 16
MIX_WIDTH = D_MODEL
SSM_WIDTH = MIX_WIDTH // 2
POOL_WIDTH = MIX_WIDTH - SSM_WIDTH
SSM_GROUP_CH = 16
SSM_GROUPS = SSM_WIDTH // SSM_GROUP_CH
SSM_STATE = 64
DT_MIN = 1e-3
DT_MAX = 1e-1
POOL_WINDOWS = (2, 4, 8, 16)
POOL_GROUPS = len(POOL_WINDOWS)
POOL_GROUP = POOL_WIDTH // POOL_GROUPS
D_FF = ((8 * D_MODEL // 3 + 127) // 128) * 128
RMS_EPS = 1e-6

kernel_name = "hymba_s5_poolformer_macaron_layer"


def rms_norm(x, g):
    xf = x.astype(jnp.float32)
    y = xf * lax.rsqrt(jnp.mean(xf * xf, axis=-1, keepdims=True) + RMS_EPS)
    return (y * g.astype(jnp.float32)).astype(x.dtype)


def swiglu(h, w_gate, w_up, w_down):
    return (jax.nn.silu(h @ w_gate) * (h @ w_up)) @ w_down


def _complex_scan_combine(e1, e2):
    a1r, a1i, b1r, b1i = e1
    a2r, a2i, b2r, b2i = e2
    ar = a2r * a1r - a2i * a1i
    ai = a2r * a1i + a2i * a1r
    a2r_b = a2r[:, None]
    a2i_b = a2i[:, None]
    br = a2r_b * b1r - a2i_b * b1i + b2r
    bi = a2r_b * b1i + a2i_b * b1r + b2i
    return (ar, ai, br, bi)


def s5_mixer(u, lam_re, lam_im, log_dt, b_re, b_im, c_re, c_im, d_skip, w_glu):
    Bt, L, _ = u.shape
    ug = u.astype(jnp.float32).reshape(Bt, L, SSM_GROUPS, SSM_GROUP_CH)
    lr = lam_re.astype(jnp.float32)
    li = lam_im.astype(jnp.float32)
    dt = jnp.exp(log_dt.astype(jnp.float32))[:, None]
    decay = jnp.exp(lr * dt)
    ang = li * dt
    a_re = decay * jnp.cos(ang)
    a_im = decay * jnp.sin(ang)
    nr = a_re - 1.0
    den = lr * lr + li * li
    q_re = (nr * lr + a_im * li) / den
    q_im = (a_im * lr - nr * li) / den
    br = b_re.astype(jnp.float32)
    bi = b_im.astype(jnp.float32)
    bb_re = q_re[..., None] * br - q_im[..., None] * bi
    bb_im = q_re[..., None] * bi + q_im[..., None] * br
    bu_re = jnp.einsum('blgh,gnh->lbgn', ug, bb_re)
    bu_im = jnp.einsum('blgh,gnh->lbgn', ug, bb_im)
    A_re = jnp.broadcast_to(a_re, (L,) + a_re.shape)
    A_im = jnp.broadcast_to(a_im, (L,) + a_im.shape)
    _, _, x_re, x_im = lax.associative_scan(_complex_scan_combine, (A_re, A_im, bu_re, bu_im), axis=0)
    y = (jnp.einsum('lbgn,ghn->blgh', x_re, c_re.astype(jnp.float32))
         - jnp.einsum('lbgn,ghn->blgh', x_im, c_im.astype(jnp.float32)))
    y = y + d_skip.astype(jnp.float32).reshape(SSM_GROUPS, SSM_GROUP_CH) * ug
    z = jnp.einsum('blgh,ghk->blgk', jax.nn.gelu(y), w_glu.astype(jnp.float32))
    out = z[..., :SSM_GROUP_CH] * jax.nn.sigmoid(z[..., SSM_GROUP_CH:])
    return out.reshape(Bt, L, SSM_WIDTH).astype(u.dtype)


def pool_mixer(u, pool_w, pool_scale):
    Bt, L, _ = u.shape
    uf = u.astype(jnp.float32)
    cs = jnp.cumsum(uf, axis=1)
    cs = jnp.concatenate([jnp.zeros((Bt, 1, POOL_WIDTH), jnp.float32), cs], axis=1)
    t1 = jnp.arange(1, L + 1, dtype=jnp.float32)
    outs = []
    for gi, w in enumerate(POOL_WINDOWS):
        lo_c, hi_c = gi * POOL_GROUP, (gi + 1) * POOL_GROUP
        c = cs[:, :, lo_c:hi_c]
        hi = c[:, 1:]
        lo = jnp.concatenate([jnp.zeros((Bt, w - 1, POOL_GROUP), jnp.float32), c[:, :L - w + 1]], axis=1)
        cnt = jnp.minimum(t1, float(w))[None, :, None]
        outs.append((hi - lo) / cnt - uf[:, :, lo_c:hi_c])
    pooled = jnp.stack(outs, axis=2)
    mixed = jnp.einsum('blgc,gcd->blgd', pooled, pool_w.astype(jnp.float32))
    mixed = mixed * pool_scale.astype(jnp.float32).reshape(POOL_GROUPS, POOL_GROUP)
    return mixed.reshape(Bt, L, POOL_WIDTH).astype(u.dtype)


def setup_inputs(seed: int = 0) -> dict:
    key = jax.random.key(seed)
    ks = jax.random.split(key, 40)
    f32 = jnp.float32

    def nrm(k, shape, scale):
        return jax.random.normal(k, shape, f32) * scale

    def gain(k, shape):
        return 1.0 + 0.02 * jax.random.normal(k, shape, f32)

    Dp = DEPTH
    G, N, H = SSM_GROUPS, SSM_STATE, SSM_GROUP_CH
    n_idx = jnp.arange(N, dtype=f32)
    return {
        "x": nrm(ks[0], (BATCH, SEQ, D_MODEL), 1.0),
        "meta_tokens": nrm(ks[1], (N_META, D_MODEL), 1.0),
        "ffn1_pre_norm": gain(ks[2], (Dp, D_MODEL)),
        "ffn1_post_norm": gain(ks[3], (Dp, D_MODEL)),
        "ffn1_w_gate": nrm(ks[4], (Dp, D_MODEL, D_FF), D_MODEL ** -0.5),
        "ffn1_w_up": nrm(ks[5], (Dp, D_MODEL, D_FF), D_MODEL ** -0.5),
        "ffn1_w_down": nrm(ks[6], (Dp, D_FF, D_MODEL), D_FF ** -0.5),
        "mix_pre_norm": gain(ks[7], (Dp, D_MODEL)),
        "mix_post_norm": gain(ks[8], (Dp, D_MODEL)),
        "w_in": nrm(ks[9], (Dp, D_MODEL, MIX_WIDTH), D_MODEL ** -0.5),
        "ssm_lambda_re": -0.5 + 0.01 * jax.random.normal(ks[10], (Dp, G, N), f32),
        "ssm_lambda_im": math.pi * n_idx + 0.01 * jax.random.normal(ks[11], (Dp, G, N), f32),
        "ssm_log_dt": jax.random.uniform(ks[12], (Dp, G), f32, math.log(DT_MIN), math.log(DT_MAX)),
        "ssm_b_re": nrm(ks[13], (Dp, G, N, H), (2.0 * H) ** -0.5),
        "ssm_b_im": nrm(ks[14], (Dp, G, N, H), (2.0 * H) ** -0.5),
        "ssm_c_re": nrm(ks[15], (Dp, G, H, N), (2.0 * N) ** -0.5),
        "ssm_c_im": nrm(ks[16], (Dp, G, H, N), (2.0 * N) ** -0.5),
        "ssm_d": nrm(ks[17], (Dp, SSM_WIDTH), 1.0),
        "ssm_w_glu": nrm(ks[18], (Dp, G, H, 2 * H), H ** -0.5),
        "pool_w": nrm(ks[19], (Dp, POOL_GROUPS, POOL_GROUP, POOL_GROUP), POOL_GROUP ** -0.5),
        "pool_scale": gain(ks[20], (Dp, POOL_WIDTH)),
        "ssm_out_norm": gain(ks[21], (Dp, SSM_WIDTH)),
        "pool_out_norm": gain(ks[22], (Dp, POOL_WIDTH)),
        "w_out": nrm(ks[23], (Dp, MIX_WIDTH, D_MODEL), MIX_WIDTH ** -0.5),
        "ffn2_pre_norm": gain(ks[24], (Dp, D_MODEL)),
        "ffn2_post_norm": gain(ks[25], (Dp, D_MODEL)),
        "ffn2_w_gate": nrm(ks[26], (Dp, D_MODEL, D_FF), D_MODEL ** -0.5),
        "ffn2_w_up": nrm(ks[27], (Dp, D_MODEL, D_FF), D_MODEL ** -0.5),
        "ffn2_w_down": nrm(ks[28], (Dp, D_FF, D_MODEL), D_FF ** -0.5),
    }


def reference(x, meta_tokens, ffn1_pre_norm, ffn1_post_norm, ffn1_w_gate, ffn1_w_up, ffn1_w_down,
              mix_pre_norm, mix_post_norm, w_in, ssm_lambda_re, ssm_lambda_im, ssm_log_dt,
              ssm_b_re, ssm_b_im, ssm_c_re, ssm_c_im, ssm_d, ssm_w_glu, pool_w, pool_scale,
              ssm_out_norm, pool_out_norm, w_out, ffn2_pre_norm, ffn2_post_norm,
              ffn2_w_gate, ffn2_w_up, ffn2_w_down):
    Bt = x.shape[0]
    meta = jnp.broadcast_to(meta_tokens.astype(x.dtype)[None], (Bt, N_META, D_MODEL))
    h = jnp.concatenate([meta, x], axis=1)
    for i in range(DEPTH):
        f = swiglu(rms_norm(h, ffn1_pre_norm[i]), ffn1_w_gate[i], ffn1_w_up[i], ffn1_w_down[i])
        h = h + 0.5 * rms_norm(f, ffn1_post_norm[i])
        proj = rms_norm(h, mix_pre_norm[i]) @ w_in[i]
        y_ssm = s5_mixer(proj[..., :SSM_WIDTH], ssm_lambda_re[i], ssm_lambda_im[i], ssm_log_dt[i],
                         ssm_b_re[i], ssm_b_im[i], ssm_c_re[i], ssm_c_im[i], ssm_d[i], ssm_w_glu[i])
        y_pool = pool_mixer(proj[..., SSM_WIDTH:], pool_w[i], pool_scale[i])
        mixed = jnp.concatenate([rms_norm(y_ssm, ssm_out_norm[i]),
                                 rms_norm(y_pool, pool_out_norm[i])], axis=-1) @ w_out[i]
        h = h + rms_norm(mixed, mix_post_norm[i])
        f = swiglu(rms_norm(h, ffn2_pre_norm[i]), ffn2_w_gate[i], ffn2_w_up[i], ffn2_w_down[i])
        h = h + 0.5 * rms_norm(f, ffn2_post_norm[i])
    return h[:, N_META:]
```

```cpp
#include <hip/hip_runtime.h>
#include <hip/hip_cooperative_groups.h>
#include <cstdio>
namespace cg = cooperative_groups;

#define LAS __attribute__((address_space(3)))
typedef unsigned short bf16_t;
typedef short bf16x8 __attribute__((ext_vector_type(8)));
typedef short bf16x4 __attribute__((ext_vector_type(4)));
typedef float f32x4 __attribute__((ext_vector_type(4)));
typedef unsigned u32x4 __attribute__((ext_vector_type(4)));
typedef unsigned u32x2 __attribute__((ext_vector_type(2)));

constexpr int MTOK = 65536;
constexpr int DM = 1024, FF = 2816, NCHUNK = 1024, KY = 1152;
constexpr float EPS = 1e-6f;
constexpr int NTHREADS = 512, NWAVES = 8;

constexpr size_t al256(size_t x) { return (x + 255) & ~(size_t)255; }
constexpr size_t WS_CTL   = 0;
constexpr size_t WS_WGU1  = 65536;
constexpr size_t SZ_WGU   = (size_t)2 * FF * DM * 2;
constexpr size_t WS_WD1   = WS_WGU1 + SZ_WGU;
constexpr size_t SZ_WD    = (size_t)DM * FF * 2;
constexpr size_t WS_WGU2  = WS_WD1 + SZ_WD;
constexpr size_t WS_WD2   = WS_WGU2 + SZ_WGU;
constexpr size_t WS_WIN   = WS_WD2 + SZ_WD;
constexpr size_t WS_WOUT  = WS_WIN + (size_t)DM * DM * 2;
constexpr size_t WS_M1    = WS_WOUT + (size_t)DM * DM * 2;
constexpr size_t SZ_M1    = (size_t)32 * 1024 * KY * 2;
constexpr size_t WS_W2    = WS_M1 + SZ_M1;
constexpr size_t SZ_W2    = (size_t)32 * 256 * 1024 * 2;
constexpr size_t WS_KTAB  = WS_W2 + SZ_W2;
constexpr size_t SZ_KTAB  = (size_t)32 * 64 * 256 * 4;
constexpr size_t WS_XN1M  = WS_KTAB + SZ_KTAB;
constexpr size_t WS_GM    = WS_XN1M + 16 * DM * 2;
constexpr size_t WS_F1M   = al256(WS_GM + 16 * FF * 2);
constexpr size_t WS_XN2M  = WS_F1M + 16 * DM * 4;
constexpr size_t WS_PROJM = WS_XN2M + 16 * DM * 2;
constexpr size_t WS_XN    = WS_PROJM + 16 * DM * 4;
constexpr size_t WS_F     = WS_XN + (size_t)MTOK * DM * 2;
constexpr size_t WS_SSQ   = WS_F + (size_t)MTOK * DM * 2;
constexpr size_t WS_GBUF  = WS_SSQ + (size_t)MTOK * 16 * 4;
constexpr size_t SZ_GBUF  = (size_t)MTOK * FF * 2;
constexpr size_t WS_UG    = WS_GBUF;
constexpr size_t SZ_UG    = (size_t)32 * 1024 * KY * 2;
constexpr size_t WS_V     = WS_UG + SZ_UG;
constexpr int VROWS = 8 * (8192 + 16);
constexpr size_t WS_S     = WS_V + (size_t)VROWS * 512 * 2;
constexpr size_t WS_END0  = WS_GBUF + SZ_GBUF;
constexpr size_t WS_OS    = WS_END0;
constexpr size_t WS_SSQS  = WS_OS + (size_t)MTOK * 512 * 2;
constexpr size_t WS_H     = WS_SSQS + (size_t)MTOK * 32 * 4;
constexpr size_t WS_EQ    = WS_H + (size_t)MTOK * DM * 2;
constexpr size_t WS_EP    = WS_EQ + (size_t)32 * 64 * 64 * 8;
constexpr size_t WS_RS    = WS_EP + (size_t)32 * 65 * 64 * 8;
constexpr size_t WS_END   = WS_RS + (size_t)MTOK * 4;
static_assert(WS_S + (size_t)2 * 32 * 1024 * 128 * 4 <= WS_END0, "alias region overflow");

struct Params { const float* in[29]; float* out; unsigned char* ws; };

typedef float f32x2c __attribute__((ext_vector_type(2)));
typedef __bf16 bf16x2c __attribute__((ext_vector_type(2)));
__device__ __forceinline__ unsigned cvt_pk_bf16(float lo, float hi) { const f32x2c v = {lo, hi}; const bf16x2c r = __builtin_convertvector(v, bf16x2c); return __builtin_bit_cast(unsigned, r); }
__device__ __forceinline__ float bf_lo(unsigned w) { return __uint_as_float(w << 16); }
__device__ __forceinline__ float bf_hi(unsigned w) { return __uint_as_float(w & 0xffff0000u); }
__device__ __forceinline__ float wave_sum(float v) {
#pragma unroll
    for (int o = 1; o < 64; o <<= 1) v += __shfl_xor(v, o);
    return v;
}
__device__ __forceinline__ float fast_sigmoid(float z) { return __builtin_amdgcn_rcpf(1.0f + __builtin_amdgcn_exp2f(-1.4426950408889634f * z)); }
__device__ __forceinline__ float silu_f(float x) { return x * fast_sigmoid(x); }
__device__ __forceinline__ float gelu_tanh_f(float x) { const float z = 0.7978845608028654f * (x + 0.044715f * x * x * x); return x * fast_sigmoid(2.0f * z); }
__device__ __forceinline__ float rsq(float x) { return 1.0f / sqrtf(x); }

struct SsmP { const float *lre, *lim, *logdt, *bre, *bim, *cre, *cim, *dskip, *wglu; };
__device__ __forceinline__ void ssm_apow(const SsmP& P, int g, int n, float p, float& er, float& ei) {
    const float dt = expf(P.logdt[g]); const float lr = P.lre[g * 64 + n], li = P.lim[g * 64 + n];
    const float mag = expf(lr * dt * p);
    double turns = (double)li * (double)dt * (double)p * 0.15915494309189535;
    turns -= rint(turns);
    const float tf = (float)turns;
    er = mag * __builtin_amdgcn_cosf(tf); ei = mag * __builtin_amdgcn_sinf(tf);
}
__device__ __forceinline__ void ssm_q(const SsmP& P, int g, int n, float& qr, float& qi) {
    const float dt = expf(P.logdt[g]); const float lr = P.lre[g * 64 + n], li = P.lim[g * 64 + n];
    const float em1 = expm1f(lr * dt), decay = 1.0f + em1;
    double turns = (double)li * (double)dt * 0.15915494309189535;
    double t1 = turns - rint(turns); double t2 = turns * 0.5; t2 -= rint(t2);
    const float c = __builtin_amdgcn_cosf((float)t1), s = __builtin_amdgcn_sinf((float)t1), sh = __builtin_amdgcn_sinf((float)t2);
    const float ai = decay * s;
    const float nr = em1 * c - 2.0f * sh * sh;
    const float den = lr * lr + li * li;
    qr = (nr * lr + ai * li) / den; qi = (ai * lr - nr * li) / den;
}

constexpr int BM = 256, BK = 64, HALF = 128, HTB = HALF * BK * 2, STAGE_BYTES = 8 * HTB, NXCD = 8, WGM = 8;
__device__ __forceinline__ int lds_byte(int r, int c) { const int st = (r >> 4) * 2 + (c >> 5), rr = r & 15, cc = c & 31, ob = rr * 64 + cc * 2; return st * 1024 + (ob ^ (((ob >> 9) & 1) << 5)); }
__device__ __forceinline__ void stage_rc(int b, int& R, int& C) { const int st = b / 1024, sb = b % 1024, swz = sb ^ (((sb >> 9) & 1) << 5); R = (st >> 1) * 16 + swz / 64; C = (st & 1) * 32 + (swz % 64) / 2; }
__device__ __forceinline__ int perm32(int rho) { const int n = rho >> 4, i = rho & 15; return 8 * (i >> 2) + 4 * n + (i & 3); }

struct Unit { int pm, pn, g, kofs, kofsA, nt; };
struct Gemm { const bf16_t* A; const bf16_t* Bt; int lda, ldb, K; size_t gsA, gsB; };

struct StaticOrder {
    int nM, nN, nwg, G, c;
    __device__ void init(int M, int N, int G_, int c_) { nM = M / BM; nN = N / BM; nwg = nM * nN; G = G_; c = c_; }
    __device__ bool next(int i, Unit& u) const {
        const long L = (long)i * G + c; if (L >= nwg) return false;
        int wgid = (int)L; { const int q = nwg / NXCD, r = nwg % NXCD, xcd = wgid % NXCD, off = wgid / NXCD; wgid = (xcd < r ? xcd * (q + 1) : r * (q + 1) + (xcd - r) * q) + off; }
        const int nig = WGM * nN, gid = wgid / nig, fm = gid * WGM, gsz = (nM - fm) < WGM ? (nM - fm) : WGM;
        u.pm = fm + ((wgid % nig) % gsz); u.pn = (wgid % nig) / gsz; u.g = 0; u.kofs = 0; u.kofsA = 0; u.nt = 0; return true;
    }
};
struct OrderS {
    int G, c;
    __device__ bool next(int i, Unit& u) const { const int L = i * G + c; if (L >= 256) return false; u.g = L >> 3; u.pm = (L >> 1) & 3; u.pn = 0; u.kofs = (L & 1) * 1024; u.kofsA = 256; u.nt = 0; return true; }
};
struct OrderY {
    int G, c;
    __device__ bool next(int i, Unit& u) const { const int L = i * G + c; if (L >= 512) return false; const int l = L & 255;
        u.g = l >> 3; u.pm = (l >> 1) & 3; u.pn = (L < 256) ? (l & 1) : 3 - (l & 1); u.kofs = 0; u.kofsA = 0; u.nt = 2 + 4 * (u.pn + 1); return true; }
};

typedef f32x4 Acc[2][2][4][2];

struct EpiSwiGLU {
    static constexpr bool PERM = true;
    bf16_t* G; const float* RS;
    static constexpr bool USES_RS = true;
    __device__ __forceinline__ void operator()(const Acc& acc, const Unit& u, int wr, int wc, int fr, int fq, const LAS float* rsl) const {
        const int row0 = u.pm * BM + wr * 64 + fr, col0 = u.pn * 128 + wc * 32 + 8 * fq;
        float rsv[2][4];
#pragma unroll
        for (int ai = 0; ai < 2; ++ai)
#pragma unroll
            for (int m = 0; m < 4; ++m) rsv[ai][m] = rsl[ai * HALF + wr * 64 + m * 16 + fr];
#pragma unroll
        for (int ai = 0; ai < 2; ++ai)
#pragma unroll
            for (int m = 0; m < 4; ++m) {
                bf16_t* rowp = G + (size_t)(row0 + ai * HALF + m * 16) * FF + col0; const float rs = rsv[ai][m];
                const f32x4 g0 = acc[ai][0][m][0] * rs, g1 = acc[ai][0][m][1] * rs, u0 = acc[ai][1][m][0] * rs, u1 = acc[ai][1][m][1] * rs;
                u32x4 w;
                w.x = cvt_pk_bf16(silu_f(g0[0]) * u0[0], silu_f(g0[1]) * u0[1]); w.y = cvt_pk_bf16(silu_f(g0[2]) * u0[2], silu_f(g0[3]) * u0[3]);
                w.z = cvt_pk_bf16(silu_f(g1[0]) * u1[0], silu_f(g1[1]) * u1[1]); w.w = cvt_pk_bf16(silu_f(g1[2]) * u1[2], silu_f(g1[3]) * u1[3]);
                *(u32x4*)rowp = w;
            }
    }
};
template <bool SCALED> struct EpiRowSsqT {
    static constexpr bool PERM = true;
    bf16_t* F; float* SSQ; const float* RS = nullptr;
    static constexpr bool USES_RS = SCALED;
    __device__ __forceinline__ void operator()(const Acc& acc, const Unit& u, int wr, int wc, int fr, int fq, const LAS float* rsl) const {
        const int row0 = u.pm * BM + wr * 64 + fr, col0 = u.pn * BM + wc * 32 + 8 * fq;
        float rsv[2][4];
#pragma unroll
        for (int ai = 0; ai < 2; ++ai)
#pragma unroll
            for (int m = 0; m < 4; ++m) rsv[ai][m] = SCALED ? rsl[ai * HALF + wr * 64 + m * 16 + fr] : 1.0f;
#pragma unroll
        for (int ai = 0; ai < 2; ++ai)
#pragma unroll
            for (int m = 0; m < 4; ++m) {
                const int row = row0 + ai * HALF + m * 16;
                bf16_t* rowp = F + (size_t)row * DM + col0; float s = 0.f;
#pragma unroll
                for (int bj = 0; bj < 2; ++bj) {
                    const f32x4 v0 = acc[ai][bj][m][0] * rsv[ai][m], v1 = acc[ai][bj][m][1] * rsv[ai][m];
                    s += (v0[0] * v0[0] + v0[1] * v0[1]) + (v0[2] * v0[2] + v0[3] * v0[3]) + (v1[0] * v1[0] + v1[1] * v1[1]) + (v1[2] * v1[2] + v1[3] * v1[3]);
                    u32x4 w; w.x = cvt_pk_bf16(v0[0], v0[1]); w.y = cvt_pk_bf16(v0[2], v0[3]); w.z = cvt_pk_bf16(v1[0], v1[1]); w.w = cvt_pk_bf16(v1[2], v1[3]);
                    *(u32x4*)(rowp + bj * HALF) = w;
                }
                s += __shfl_xor(s, 16); s += __shfl_xor(s, 32);
                if (fq == 0) SSQ[(size_t)row * 16 + u.pn * 4 + wc] = s;
            }
    }
};
typedef EpiRowSsqT<false> EpiRowSsq; typedef EpiRowSsqT<true> EpiRowSsqScaled;
struct EpiProj {
    static constexpr bool PERM = true;
    bf16_t* UG; bf16_t* V; const float* RS;
    static constexpr bool USES_RS = true;
    __device__ __forceinline__ void operator()(const Acc& acc, const Unit& u, int wr, int wc, int fr, int fq, const LAS float* rsl) const {
        const int row0 = u.pm * BM + wr * 64 + fr;
        float rsv[2][4];
#pragma unroll
        for (int ai = 0; ai < 2; ++ai)
#pragma unroll
            for (int m = 0; m < 4; ++m) rsv[ai][m] = rsl[ai * HALF + wr * 64 + m * 16 + fr];
#pragma unroll
        for (int ai = 0; ai < 2; ++ai)
#pragma unroll
            for (int m = 0; m < 4; ++m) {
                const int row = row0 + ai * HALF + m * 16; const float rs = rsv[ai][m];
#pragma unroll
                for (int bj = 0; bj < 2; ++bj) {
                    const int c0 = u.pn * BM + bj * HALF + wc * 32 + 8 * fq;
                    const f32x4 v0 = acc[ai][bj][m][0] * rs, v1 = acc[ai][bj][m][1] * rs;
                    u32x4 w; w.x = cvt_pk_bf16(v0[0], v0[1]); w.y = cvt_pk_bf16(v0[2], v0[3]); w.z = cvt_pk_bf16(v1[0], v1[1]); w.w = cvt_pk_bf16(v1[2], v1[3]);
                    bf16_t* dst;
                    if (u.pn < 2) { const int g = c0 >> 4, ch0 = c0 & 15, chunk = row >> 6, t = row & 63; dst = UG + ((size_t)(g * NCHUNK + chunk) * KY + 128 + t * 16 + ch0); }
                    else dst = V + (size_t)(row + 16 * ((row >> 13) + 1)) * 512 + (c0 - 512);
                    *(u32x4*)dst = w;
                }
            }
    }
};
struct EpiS {
    static constexpr bool PERM = false;
    float* S;
    static constexpr bool USES_RS = false; const float* RS = nullptr;
    __device__ __forceinline__ void operator()(const Acc& acc, const Unit& u, int wr, int wc, int fr, int fq, const LAS float* rsl) const {
        const int row0 = u.pm * BM + wr * 64 + fr, col0 = wc * 32 + 4 * fq;
#pragma unroll
        for (int ai = 0; ai < 2; ++ai)
#pragma unroll
            for (int m = 0; m < 4; ++m) {
                float* rowp = S + (u.kofs ? (size_t)32 * NCHUNK * 128 : (size_t)0) + ((size_t)u.g * NCHUNK + row0 + ai * HALF + m * 16) * 128 + col0;
#pragma unroll
                for (int n = 0; n < 2; ++n) *(f32x4*)(rowp + n * 16) = acc[ai][0][m][n];
            }
    }
};
struct EpiY {
    static constexpr bool PERM = false;
    const float* wglu; bf16_t* OS; float* SSQS;
    static constexpr bool USES_RS = false; const float* RS = nullptr;
    __device__ __forceinline__ void operator()(const Acc& acc, const Unit& u, int wr, int wc, int fr, int fq, const LAS float* rsl) const {
        const float* wp = wglu + ((size_t)u.g * 16 + 4 * fq) * 32 + fr;
        bf16x4 wv, wg;
        { float wl[8];
#pragma unroll
          for (int q = 0; q < 8; ++q) wl[q] = wp[16 * q];
          const unsigned a0 = cvt_pk_bf16(wl[0], wl[2]), a1 = cvt_pk_bf16(wl[4], wl[6]); wv[0] = (short)(a0 & 0xffff); wv[1] = (short)(a0 >> 16); wv[2] = (short)(a1 & 0xffff); wv[3] = (short)(a1 >> 16);
          const unsigned b0 = cvt_pk_bf16(wl[1], wl[3]), b1 = cvt_pk_bf16(wl[5], wl[7]); wg[0] = (short)(b0 & 0xffff); wg[1] = (short)(b0 >> 16); wg[2] = (short)(b1 & 0xffff); wg[3] = (short)(b1 >> 16); }
#pragma unroll
        for (int ai = 0; ai < 2; ++ai)
#pragma unroll
            for (int m = 0; m < 4; ++m) {
                const int chunk = u.pm * BM + ai * HALF + wr * 64 + m * 16 + fr;
#pragma unroll
                for (int bj = 0; bj < 2; ++bj)
#pragma unroll
                    for (int n = 0; n < 2; ++n) {
                        const f32x4 a = acc[ai][bj][m][n];
                        const unsigned p0 = cvt_pk_bf16(gelu_tanh_f(a[0]), gelu_tanh_f(a[1])), p1 = cvt_pk_bf16(gelu_tanh_f(a[2]), gelu_tanh_f(a[3]));
                        bf16x4 gy; gy[0] = (short)(p0 & 0xffff); gy[1] = (short)(p0 >> 16); gy[2] = (short)(p1 & 0xffff); gy[3] = (short)(p1 >> 16);
                        const f32x4 z0 = {0.f, 0.f, 0.f, 0.f};
                        const f32x4 zv = __builtin_amdgcn_mfma_f32_16x16x16bf16_1k(wv, gy, z0, 0, 0, 0);
                        const f32x4 zg = __builtin_amdgcn_mfma_f32_16x16x16bf16_1k(wg, gy, z0, 0, 0, 0);
                        const float o0 = zv[0] * fast_sigmoid(zg[0]), o1 = zv[1] * fast_sigmoid(zg[1]), o2 = zv[2] * fast_sigmoid(zg[2]), o3 = zv[3] * fast_sigmoid(zg[3]);
                        const int t = u.pn * 16 + bj * 8 + wc * 2 + n; const size_t token = (size_t)chunk * 64 + t;
                        u32x2 w; w.x = cvt_pk_bf16(o0, o1); w.y = cvt_pk_bf16(o2, o3);
                        *(u32x2*)(OS + token * DM + u.g * 16 + 4 * fq) = w;
                        float s = (o0 * o0 + o1 * o1) + (o2 * o2 + o3 * o3);
                        s += __shfl_xor(s, 16); s += __shfl_xor(s, 32);
                        if (fq == 0) SSQS[((size_t)(u.g * 4 + u.pn) * NCHUNK + chunk) * 16 + (t & 15)] = s;
                    }
            }
    }
};

template <class Epi, class Sched>
__device__ __forceinline__ void gemm_phase(LAS unsigned char* lds, const Gemm g, const Sched& S, const Epi& E) {
    int tid = threadIdx.x; asm volatile("" : "+v"(tid));
    const int wid = __builtin_amdgcn_readfirstlane(tid >> 6), lane = tid & 63, wr = wid >> 2, wc = wid & 3, fr = lane & 15, fq = lane >> 4;
    const int ntK = g.K / BK;
    unsigned voffA[2], voffB[2];
#pragma unroll
    for (int i = 0; i < 2; ++i) { int R, C; stage_rc(tid * 16 + i * 8192, R, C); const int Rb = Epi::PERM ? ((R & ~31) + perm32(R & 31)) : R;
        voffA[i] = (unsigned)(R * g.lda + C) * 2u; voffB[i] = (unsigned)(Rb * g.ldb + C) * 2u; }
    const size_t kstep = (size_t)(BK * 2);
    const size_t hstepA = (size_t)HALF * g.lda * 2, hstepB = (size_t)HALF * g.ldb * 2;
    const size_t tstepA = 2 * hstepA, tstepB = 2 * hstepB;
    const unsigned ldsw = (unsigned)wid * 1024u;
    const int aoff = lds_byte(wr * 64 + fr, fq * 8), boff = lds_byte(wc * 32 + fr, fq * 8);
#define PG8_SA(b, h) (((b) * 2 + (h)) * HTB)
#define PG8_SB(b, h) ((4 + (b) * 2 + (h)) * HTB)
#define PG8_STAGE(bufoff, gbase, voff) do { _Pragma("unroll") for (int _i = 0; _i < 2; ++_i) \
        __builtin_amdgcn_global_load_lds((const unsigned*)((const char*)(gbase) + (voff)[_i]), (LAS unsigned*)(lds + (bufoff) + ldsw + _i * 8192), 16, 0, 0); } while (0)
#define PG8_LDA(dst, b, h) do { _Pragma("unroll") for (int m = 0; m < 4; ++m) _Pragma("unroll") for (int k = 0; k < 2; ++k) dst[m][k] = *(const LAS bf16x8*)(lds + PG8_SA(b, h) + aoff + m * 2048 + k * 1024); } while (0)
#define PG8_LDB(dst, b, h) do { _Pragma("unroll") for (int n = 0; n < 2; ++n) _Pragma("unroll") for (int k = 0; k < 2; ++k) dst[n][k] = *(const LAS bf16x8*)(lds + PG8_SB(b, h) + boff + n * 2048 + k * 1024); } while (0)
#define PG8_MMA(ai, bj, At, Bt) do { __builtin_amdgcn_s_setprio(1); _Pragma("unroll") for (int m = 0; m < 4; ++m) _Pragma("unroll") for (int n = 0; n < 2; ++n) _Pragma("unroll") for (int k = 0; k < 2; ++k) \
        acc[ai][bj][m][n] = __builtin_amdgcn_mfma_f32_16x16x32_bf16(Bt[n][k], At[m][k], acc[ai][bj][m][n], 0, 0, 0); __builtin_amdgcn_s_setprio(0); } while (0)
#define PG8_WAIT_V(n) asm volatile("s_waitcnt vmcnt(" #n ")" ::: "memory")
#define PG8_WAIT_L(n) asm volatile("s_waitcnt lgkmcnt(" #n ")" ::: "memory")
#define PG8_BAR __builtin_amdgcn_s_barrier()
#define PG8_SCHED __builtin_amdgcn_sched_barrier(0)
    Unit cur, nxt; int ui = 0;
    if (!S.next(0, cur)) return;
    Acc acc;
#pragma unroll
    for (int a = 0; a < 2; ++a)
#pragma unroll
        for (int b = 0; b < 2; ++b)
#pragma unroll
            for (int m = 0; m < 4; ++m)
#pragma unroll
                for (int n = 0; n < 2; ++n) acc[a][b][m][n] = (f32x4){0.f, 0.f, 0.f, 0.f};
    bf16x8 At[4][2], B0[2][2], B1[2][2];
    int nt = cur.nt ? cur.nt : ntK;
    LAS float* rstab = (LAS float*)(lds + STAGE_BYTES + 1024);
    if constexpr (Epi::USES_RS) { if (wid == 0) __builtin_amdgcn_global_load_lds((const unsigned*)(E.RS + (size_t)cur.pm * BM + lane * 4), (LAS unsigned*)(rstab), 16, 0, 0); }
    const char* cA = (const char*)g.A + (size_t)cur.g * g.gsA + (size_t)cur.pm * tstepA + cur.kofs + cur.kofsA;
    const char* cB = (const char*)g.Bt + (size_t)cur.g * g.gsB + (size_t)cur.pn * tstepB + cur.kofs;
    PG8_STAGE(PG8_SB(0, 0), cB, voffB); PG8_STAGE(PG8_SA(0, 0), cA, voffA); PG8_STAGE(PG8_SB(0, 1), cB + hstepB, voffB); PG8_STAGE(PG8_SA(0, 1), cA + hstepA, voffA);
    if (wr == 1) PG8_BAR;
    PG8_WAIT_V(4); PG8_BAR;
    PG8_STAGE(PG8_SB(1, 0), cB + kstep, voffB); PG8_STAGE(PG8_SA(1, 0), cA + kstep, voffA); PG8_STAGE(PG8_SB(1, 1), cB + hstepB + kstep, voffB);
    PG8_WAIT_V(6); PG8_BAR;
    for (;;) {
        const bool has_next = S.next(ui + 1, nxt);
        const char* nA = has_next ? (const char*)g.A + (size_t)nxt.g * g.gsA + (size_t)nxt.pm * tstepA + nxt.kofs + nxt.kofsA : cA;
        const char* nB = has_next ? (const char*)g.Bt + (size_t)nxt.g * g.gsB + (size_t)nxt.pn * tstepB + nxt.kofs : cB;
        for (int t = 0; t < nt; t += 2) {
            const bool last = (t == nt - 2);
            const char* a1 = cA + (size_t)(t + 1) * kstep;
            const char* a2 = last ? nA : cA + (size_t)(t + 2) * kstep; const char* b2 = last ? nB : cB + (size_t)(t + 2) * kstep;
            const char* a3 = a2 + kstep; const char* b3 = b2 + kstep;
            PG8_LDB(B0, 0, 0); PG8_SCHED; PG8_LDA(At, 0, 0); PG8_STAGE(PG8_SA(1, 1), a1 + hstepA, voffA);
            PG8_WAIT_L(8); PG8_BAR; PG8_WAIT_L(0); PG8_MMA(0, 0, At, B0); PG8_BAR; PG8_SCHED;
            PG8_LDB(B1, 0, 1); PG8_STAGE(PG8_SB(0, 0), b2, voffB);
            PG8_BAR; PG8_WAIT_L(0); PG8_MMA(0, 1, At, B1); PG8_BAR;
            PG8_LDA(At, 0, 1); PG8_STAGE(PG8_SA(0, 0), a2, voffA);
            PG8_BAR; PG8_WAIT_L(0); PG8_MMA(1, 0, At, B0); PG8_BAR; PG8_SCHED;
            PG8_STAGE(PG8_SB(0, 1), b2 + hstepB, voffB);
            PG8_WAIT_V(6); PG8_BAR; PG8_MMA(1, 1, At, B1); PG8_BAR;
            PG8_LDB(B0, 1, 0); PG8_SCHED; PG8_LDA(At, 1, 0); PG8_STAGE(PG8_SA(0, 1), a2 + hstepA, voffA);
            PG8_WAIT_L(8); PG8_BAR; PG8_WAIT_L(0); PG8_MMA(0, 0, At, B0); PG8_BAR; PG8_SCHED;
            PG8_LDB(B1, 1, 1); PG8_STAGE(PG8_SB(1, 0), b3, voffB);
            PG8_BAR; PG8_WAIT_L(0); PG8_MMA(0, 1, At, B1); PG8_BAR;
            PG8_LDA(At, 1, 1); PG8_STAGE(PG8_SA(1, 0), a3, voffA);
            PG8_BAR; PG8_WAIT_L(0); PG8_MMA(1, 0, At, B0); PG8_BAR; PG8_SCHED;
            PG8_STAGE(PG8_SB(1, 1), b3 + hstepB, voffB);
            PG8_WAIT_V(6); PG8_BAR; PG8_MMA(1, 1, At, B1); PG8_BAR;
        }
        E(acc, cur, wr, wc, fr, fq, rstab + (ui & 1) * 256);
        if (!has_next) break;
#pragma unroll
        for (int a = 0; a < 2; ++a)
#pragma unroll
            for (int b = 0; b < 2; ++b)
#pragma unroll
                for (int m = 0; m < 4; ++m)
#pragma unroll
                    for (int n = 0; n < 2; ++n) acc[a][b][m][n] = (f32x4){0.f, 0.f, 0.f, 0.f};
        cur = nxt; cA = nA; cB = nB; ++ui; nt = cur.nt ? cur.nt : ntK;
        if constexpr (Epi::USES_RS) { if (wid == 0) __builtin_amdgcn_global_load_lds((const unsigned*)(E.RS + (size_t)cur.pm * BM + lane * 4), (LAS unsigned*)(rstab + (ui & 1) * 256), 16, 0, 0); }
    }
    PG8_WAIT_V(0);
    if (wr == 0) PG8_BAR;
    PG8_BAR;
#undef PG8_SA
#undef PG8_SB
#undef PG8_STAGE
#undef PG8_LDA
#undef PG8_LDB
#undef PG8_MMA
#undef PG8_WAIT_V
#undef PG8_WAIT_L
#undef PG8_BAR
#undef PG8_SCHED
}

__device__ __forceinline__ f32x4 meta_tile(const bf16_t* A, const bf16_t* Brow0, int K, int ldb, int lane) {
    const int fr = lane & 15, fq = lane >> 4;
    const bf16_t* ap = A + (size_t)fr * K + fq * 8; const bf16_t* bp = Brow0 + (size_t)fr * ldb + fq * 8;
    f32x4 acc = {0.f, 0.f, 0.f, 0.f};
#pragma unroll 4
    for (int k = 0; k < K; k += 32) {
        const bf16x8 a = *(const bf16x8*)(ap + k), b = *(const bf16x8*)(bp + k);
        acc = __builtin_amdgcn_mfma_f32_16x16x32_bf16(b, a, acc, 0, 0, 0);
    }
    return acc;
}

__device__ __forceinline__ f32x4 meta_tile_split(const bf16_t* A, const bf16_t* Brow0, int K, int ldb, int lane, int wave, LAS f32x4* red) {
    const int fr = lane & 15, fq = lane >> 4, k0 = wave * (K >> 3), k1 = k0 + (K >> 3);
    const bf16_t* ap = A + (size_t)fr * K + fq * 8; const bf16_t* bp = Brow0 + (size_t)fr * ldb + fq * 8;
    f32x4 acc = {0.f, 0.f, 0.f, 0.f};
#pragma unroll 4
    for (int k = k0; k < k1; k += 32) {
        const bf16x8 a = *(const bf16x8*)(ap + k), b = *(const bf16x8*)(bp + k);
        acc = __builtin_amdgcn_mfma_f32_16x16x32_bf16(b, a, acc, 0, 0, 0);
    }
    red[wave * 64 + lane] = acc;
    asm volatile("s_waitcnt lgkmcnt(0)" ::: "memory"); __syncthreads();
    f32x4 t = {0.f, 0.f, 0.f, 0.f};
    if (wave == 0) {
#pragma unroll
        for (int w = 0; w < 8; ++w) t += red[w * 64 + lane];
    }
    __syncthreads();
    return t;
}

__device__ __forceinline__ void transpose_item(const float* W, int N, bf16_t* WT, int ldt, int dst_row0, LAS float* scr, int k0, int n0, int lane, const float* gk = nullptr) {
#pragma unroll
    for (int i = 0; i < 32; ++i) { const int kk = 2 * i + (lane >> 5); scr[kk * 33 + (lane & 31)] = W[(size_t)(k0 + kk) * N + n0 + (lane & 31)] * (gk ? gk[k0 + kk] : 1.0f); }
    asm volatile("s_waitcnt lgkmcnt(0)" ::: "memory");
    const int c = lane & 7;
#pragma unroll
    for (int j = 0; j < 4; ++j) { const int n = (lane >> 3) + 8 * j; const LAS float* s = scr + (8 * c) * 33 + n;
        u32x4 o; o.x = cvt_pk_bf16(s[0 * 33], s[1 * 33]); o.y = cvt_pk_bf16(s[2 * 33], s[3 * 33]); o.z = cvt_pk_bf16(s[4 * 33], s[5 * 33]); o.w = cvt_pk_bf16(s[6 * 33], s[7 * 33]);
        *(u32x4*)(WT + (size_t)(dst_row0 + n) * ldt + k0 + 8 * c) = o; }
    asm volatile("s_waitcnt lgkmcnt(0)" ::: "memory");
}

__device__ __forceinline__ void rms_row_to_bf16(const float* xrow, const float* gain, bf16_t* orow, int lane) {
    const f32x4* xr = (const f32x4*)xrow + lane; f32x4 v[4]; float s = 0.f;
#pragma unroll
    for (int j = 0; j < 4; ++j) { v[j] = xr[64 * j]; s += (v[j][0] * v[j][0] + v[j][1] * v[j][1]) + (v[j][2] * v[j][2] + v[j][3] * v[j][3]); }
    const float r = rsq(wave_sum(s) * (1.f / DM) + EPS);
    u32x2* o = (u32x2*)orow + lane;
#pragma unroll
    for (int j = 0; j < 4; ++j) { const f32x4 gq = gain ? ((const f32x4*)gain)[lane + 64 * j] : (f32x4){1.f, 1.f, 1.f, 1.f}; u32x2 w; w.x = cvt_pk_bf16(v[j][0] * r * gq[0], v[j][1] * r * gq[1]); w.y = cvt_pk_bf16(v[j][2] * r * gq[2], v[j][3] * r * gq[3]); o[64 * j] = w; }
}

__device__ __forceinline__ void e0_rows(const float* x, bf16_t* XN, float* RS, int gw, int ngw, int lane) {
        {
            const int rpw = (MTOK + ngw - 1) / ngw, mbeg = gw * rpw, mend = (mbeg + rpw < MTOK) ? mbeg + rpw : MTOK;
            for (int m0 = mbeg; m0 < mend; m0 += 8) {
                f32x4 v[8][4];
#pragma unroll
                for (int r = 0; r < 8; ++r) { const int m = (m0 + r < mend) ? m0 + r : m0;
#pragma unroll
                    for (int j = 0; j < 4; ++j) v[r][j] = ((const f32x4*)(x + (size_t)m * DM))[lane + 64 * j]; }
#pragma unroll
                for (int r = 0; r < 8; ++r) { const int m = m0 + r; if (m < mend) {
                    float ss = 0.f;
                    u32x2* o = (u32x2*)(XN + (size_t)m * DM) + lane;
#pragma unroll
                    for (int j = 0; j < 4; ++j) { ss += (v[r][j][0] * v[r][j][0] + v[r][j][1] * v[r][j][1]) + (v[r][j][2] * v[r][j][2] + v[r][j][3] * v[r][j][3]);
                        u32x2 w; w.x = cvt_pk_bf16(v[r][j][0], v[r][j][1]); w.y = cvt_pk_bf16(v[r][j][2], v[r][j][3]); o[64 * j] = w; }
                    const float rr = rsq(wave_sum(ss) * (1.f / DM) + EPS); if (lane == 0) RS[m] = rr; } }
            }
        }
}

template <bool XN_OUT, bool HIN_BF, bool HOUT_BF>
__device__ __forceinline__ void resid_rows(const void* hin_, const bf16_t* F, const float* SSQ, float coef, const float* gpost, void* hout_, float* RS, int gw, int ngw, int lane) {
    constexpr int R = 8;
    f32x4 gp[4];
#pragma unroll
    for (int j = 0; j < 4; ++j) gp[j] = ((const f32x4*)gpost)[lane + 64 * j];
    const int rpw = (MTOK + ngw - 1) / ngw, mbeg = gw * rpw, mend = (mbeg + rpw < MTOK) ? mbeg + rpw : MTOK;
    for (int m0 = mbeg; m0 < mend; m0 += R) {
        u32x2 v[R][4]; u32x2 fw[R][4]; float sqv[R];
#pragma unroll
        for (int r = 0; r < R; ++r) {
            const int m = (m0 + r < mend) ? m0 + r : m0;
            sqv[r] = SSQ[(size_t)m * 16 + (lane & 15)];
#pragma unroll
            for (int j = 0; j < 4; ++j) {
                static_assert(HIN_BF, "the residual stream is stored as bf16");
                v[r][j] = ((const u32x2*)((const bf16_t*)hin_ + (size_t)m * DM))[lane + 64 * j];
                fw[r][j] = ((const u32x2*)(F + (size_t)m * DM))[lane + 64 * j];
            }
        }
#pragma unroll
        for (int r = 0; r < R; ++r) {
            const int m = m0 + r;
            if (m < mend) {
                float ss = sqv[r]; ss += __shfl_xor(ss, 1); ss += __shfl_xor(ss, 2); ss += __shfl_xor(ss, 4); ss += __shfl_xor(ss, 8);
                const float r1 = rsq(ss * (1.f / DM) + EPS) * coef;
                f32x4 h[4]; float s2 = 0.f;
#pragma unroll
                for (int j = 0; j < 4; ++j) {
                    f32x4 vv;
                    { const unsigned w0 = v[r][j].x, w1 = v[r][j].y; vv[0] = bf_lo(w0); vv[1] = bf_hi(w0); vv[2] = bf_lo(w1); vv[3] = bf_hi(w1); }
                    f32x4 f; f[0] = bf_lo(fw[r][j].x); f[1] = bf_hi(fw[r][j].x); f[2] = bf_lo(fw[r][j].y); f[3] = bf_hi(fw[r][j].y);
                    h[j] = vv + r1 * f * gp[j];
                    s2 += (h[j][0] * h[j][0] + h[j][1] * h[j][1]) + (h[j][2] * h[j][2] + h[j][3] * h[j][3]);
                    if (HOUT_BF) { u32x2 w; w.x = cvt_pk_bf16(h[j][0], h[j][1]); w.y = cvt_pk_bf16(h[j][2], h[j][3]); ((u32x2*)((bf16_t*)hout_ + (size_t)m * DM))[lane + 64 * j] = w; }
                    else ((f32x4*)((float*)hout_ + (size_t)m * DM))[lane + 64 * j] = h[j];
                }
                if (XN_OUT) { const float r2 = rsq(wave_sum(s2) * (1.f / DM) + EPS); if (lane == 0) RS[m] = r2; }
            }
        }
    }
}

#define XB_TMO      128
#define XB_XCNT(j)  (256  + 64 * (j))
#define XB_XSUB(j)  (1280 + 64 * (j))
#define XB_XGEN(j)  (2304 + 64 * (j))
#define XB_TOP      3328
#define XB_TOPGEN   3392
#define XCD_BAR_WORDS 3456
#define XB_RANK(j)  (3520 + 64 * (j))
#define CTL_ZERO_BYTES 16384
#define XB_SPIN_CAP (1u << 22)
__device__ __forceinline__ unsigned xb_ld(unsigned* p)              { return __hip_atomic_load(p, __ATOMIC_RELAXED, __HIP_MEMORY_SCOPE_AGENT); }
__device__ __forceinline__ unsigned xb_add(unsigned* p, unsigned v) { return __hip_atomic_fetch_add(p, v, __ATOMIC_RELAXED, __HIP_MEMORY_SCOPE_AGENT); }
__device__ __forceinline__ unsigned xb_xcc_id() { return (unsigned)__builtin_amdgcn_s_getreg((3 << 11) | 20) & 0xFu; }
#define XB_SPIN(cond, bar) do { unsigned _sp = 0; while (cond) { __builtin_amdgcn_s_sleep(1); \
    if ((++_sp & 255u) == 0u) { if (xb_ld(&(bar)[XB_TMO])) break; if (_sp > XB_SPIN_CAP) { atomicAdd(&(bar)[XB_TMO], 1u); break; } } } } while (0)
struct XcdBarrier { unsigned* bar; unsigned x; volatile LAS unsigned* st; };
__device__ __forceinline__ XcdBarrier xcd_barrier_post(unsigned* bar, volatile LAS unsigned* st) {
    XcdBarrier b; b.bar = bar; b.x = xb_xcc_id(); b.st = st;
    if (threadIdx.x == 0) (void)xb_add(&bar[XB_XCNT(b.x)], 1u);
    return b;
}
__device__ __forceinline__ void xcd_barrier_complete(unsigned* bar, unsigned x, unsigned& nloc, unsigned& nx) {
    const unsigned G = gridDim.x * gridDim.y * gridDim.z;
    unsigned sum, cnt, mine, sp = 0u;
    for (;;) {
        sum = 0u; cnt = 0u; mine = 0u;
#pragma unroll
        for (unsigned j = 0; j < 16; ++j) { const unsigned c = xb_ld(&bar[XB_XCNT(j)]); sum += c; cnt += (c > 0u) ? 1u : 0u; mine = (j == x) ? c : mine; }
        if (sum == G) break;
        __builtin_amdgcn_s_sleep(1);
        if ((++sp & 255u) == 0u) { if (xb_ld(&bar[XB_TMO])) break; if (sp > XB_SPIN_CAP) { atomicAdd(&bar[XB_TMO], 1u); break; } }
    }
    nloc = mine > 0u ? mine : 1u; nx = cnt > 0u ? cnt : 1u;
}
__device__ __forceinline__ void xcd_barrier(const XcdBarrier& b) {
    asm volatile("s_waitcnt vmcnt(0)" ::: "memory");
    __syncthreads();
    if (threadIdx.x == 0) {
        unsigned* bar = b.bar;
        __builtin_amdgcn_s_waitcnt(0);
        unsigned nloc = b.st[0], nx = b.st[1];
        if (nloc == 0u) { xcd_barrier_complete(bar, b.x, nloc, nx); b.st[0] = nloc; b.st[1] = nx; }
        const unsigned old = xb_add(&bar[XB_XSUB(b.x)], 1u);
        const unsigned gen = old / nloc;
        if (old + 1u == (gen + 1u) * nloc) {
            __builtin_amdgcn_fence(__ATOMIC_RELEASE, "agent");
            asm volatile("s_waitcnt vmcnt(0)" ::: "memory");
            const unsigned og = xb_add(&bar[XB_TOP], 1u);
            const unsigned tg = og / nx;
            if (og + 1u == (tg + 1u) * nx) xb_add(&bar[XB_TOPGEN], 1u);
            else XB_SPIN(xb_ld(&bar[XB_TOPGEN]) == tg, bar);
            __builtin_amdgcn_fence(__ATOMIC_ACQUIRE, "agent");
            xb_add(&bar[XB_XGEN(b.x)], 1u);
            asm volatile("s_waitcnt vmcnt(0)" ::: "memory");
        } else {
            XB_SPIN(xb_ld(&bar[XB_XGEN(b.x)]) == gen, bar);
            __builtin_amdgcn_fence(__ATOMIC_ACQUIRE, "agent");
            asm volatile("s_waitcnt vmcnt(0)" ::: "memory");
        }
    }
    __syncthreads();
}


#define GRID_SYNC() xcd_barrier(bar)
__global__ void __launch_bounds__(NTHREADS, 2) hymba_fwd(Params p) {
    extern __shared__ __attribute__((aligned(16))) unsigned char lds_raw[];
    LAS unsigned char* lds = (LAS unsigned char*)lds_raw;
    cg::grid_group grid = cg::this_grid();
    const int tid = threadIdx.x, lane = tid & 63, wave = __builtin_amdgcn_readfirstlane(tid >> 6);
    const int G = gridDim.x, blk = blockIdx.x;
    const int gw = blk * NWAVES + wave, ngw = G * NWAVES;
    const int gt = blk * NTHREADS + tid, ngt = G * NTHREADS;
    unsigned char* ws = p.ws;
    const float* x = p.in[0]; const float* meta = p.in[1];
    SsmP sp; sp.lre = p.in[10]; sp.lim = p.in[11]; sp.logdt = p.in[12]; sp.bre = p.in[13]; sp.bim = p.in[14]; sp.cre = p.in[15]; sp.cim = p.in[16]; sp.dskip = p.in[17]; sp.wglu = p.in[18];
    bf16_t* Wgu1 = (bf16_t*)(ws + WS_WGU1); bf16_t* Wd1 = (bf16_t*)(ws + WS_WD1); bf16_t* Wgu2 = (bf16_t*)(ws + WS_WGU2); bf16_t* Wd2 = (bf16_t*)(ws + WS_WD2);
    bf16_t* Win = (bf16_t*)(ws + WS_WIN); bf16_t* Wout = (bf16_t*)(ws + WS_WOUT); bf16_t* M1 = (bf16_t*)(ws + WS_M1); bf16_t* W2 = (bf16_t*)(ws + WS_W2);
    float* Ktab = (float*)(ws + WS_KTAB);
    bf16_t* xn1m = (bf16_t*)(ws + WS_XN1M); bf16_t* Gm = (bf16_t*)(ws + WS_GM); float* f1m = (float*)(ws + WS_F1M); bf16_t* xn2m = (bf16_t*)(ws + WS_XN2M); float* projm = (float*)(ws + WS_PROJM);
    bf16_t* XN = (bf16_t*)(ws + WS_XN); bf16_t* Fb = (bf16_t*)(ws + WS_F); float* SSQ = (float*)(ws + WS_SSQ); bf16_t* Gbuf = (bf16_t*)(ws + WS_GBUF);
    bf16_t* UG = (bf16_t*)(ws + WS_UG); bf16_t* V = (bf16_t*)(ws + WS_V); bf16_t* OS = (bf16_t*)(ws + WS_OS); float* Sb = (float*)(ws + WS_S); float* SSQS = (float*)(ws + WS_SSQS);
    float* out = p.out; bf16_t* Hb = (bf16_t*)(ws + WS_H); float* EQ = (float*)(ws + WS_EQ); float* EP = (float*)(ws + WS_EP); float* RS = (float*)(ws + WS_RS);
    volatile LAS unsigned* bst = (volatile LAS unsigned*)(lds + STAGE_BYTES);
    if (tid == 0) { bst[0] = 0u; bst[1] = 0u; }
    __syncthreads();
    XcdBarrier bar = xcd_barrier_post((unsigned*)(ws + WS_CTL), bst);
    if (tid == 0) { bst[2] = xb_add((unsigned*)(ws + WS_CTL) + XB_RANK(bar.x), 1u); }
    grid.sync();

    {
        LAS float* scr = (LAS float*)(lds + wave * 16384);
        if (wave & 1) e0_rows(x, XN, RS, gw, ngw, lane);
        constexpr int I_GU = (DM / 64) * (FF / 32), I_D = (FF / 64) * (DM / 32), I_IN = (DM / 64) * (512 / 32), I_OUT = (DM / 64) * (DM / 32);
        constexpr int NIT = 4 * I_GU + 2 * I_D + I_IN + I_OUT;
        for (int it = gw; it < NIT; it += ngw) {
            int r = it;
            if (r < 4 * I_GU) {
                const int which = r / I_GU; r -= which * I_GU;
                const float* W = p.in[which == 0 ? 4 : which == 1 ? 5 : which == 2 ? 26 : 27]; bf16_t* WT = which < 2 ? Wgu1 : Wgu2;
                const int nblk = FF / 32, kb = r / nblk, nb = r % nblk, n0 = nb * 32;
                const int drow = 256 * (n0 >> 7) + (n0 & 127) + ((which & 1) ? 128 : 0);
                transpose_item(W, FF, WT, DM, drow, scr, kb * 64, n0, lane, p.in[which < 2 ? 2 : 24]); continue;
            }
            r -= 4 * I_GU;
            if (r < 2 * I_D) {
                const int which = r / I_D; r -= which * I_D;
                const float* W = p.in[which == 0 ? 6 : 28]; bf16_t* WT = which == 0 ? Wd1 : Wd2;
                const int nblk = DM / 32, kb = r / nblk, nb = r % nblk;
                transpose_item(W, DM, WT, FF, nb * 32, scr, kb * 64, nb * 32, lane); continue;
            }
            r -= 2 * I_D;
            if (r < I_IN) { const int nblk = 512 / 32, kb = r / nblk, nb = r % nblk; transpose_item(p.in[9], DM, Win, DM, nb * 32, scr, kb * 64, nb * 32, lane, p.in[7]); continue; }
            r -= I_IN;
            { const int nblk = DM / 32, kb = r / nblk, nb = r % nblk; transpose_item(p.in[23], DM, Wout, DM, nb * 32, scr, kb * 64, nb * 32, lane, kb * 64 < 512 ? p.in[21] : p.in[22] - 512); }
        }
        for (int it = gw; it < 8 * 128; it += ngw) {
            const int db = it >> 7, k0 = (it & 127) * 8, d = db * 64 + lane, gi = d >> 7, dd = d & 127;
            const float* pw = p.in[19] + (size_t)gi * 128 * 128 + dd; const float* wi = p.in[9] + (size_t)k0 * DM + 512 + gi * 128;
            float a[8];
#pragma unroll
            for (int kk = 0; kk < 8; ++kk) a[kk] = 0.f;
#pragma unroll 32
            for (int c = 0; c < 128; ++c) { const float pv = pw[(size_t)c * 128];
#pragma unroll
                for (int kk = 0; kk < 8; ++kk) a[kk] += wi[(size_t)kk * DM + c] * pv; }
            const float sc = p.in[20][d]; const f32x4 gm0 = *(const f32x4*)(p.in[7] + k0), gm1 = *(const f32x4*)(p.in[7] + k0 + 4);
            u32x4 o; o.x = cvt_pk_bf16(a[0] * sc * gm0[0], a[1] * sc * gm0[1]); o.y = cvt_pk_bf16(a[2] * sc * gm0[2], a[3] * sc * gm0[3]); o.z = cvt_pk_bf16(a[4] * sc * gm1[0], a[5] * sc * gm1[1]); o.w = cvt_pk_bf16(a[6] * sc * gm1[2], a[7] * sc * gm1[3]);
            *(u32x4*)(Win + (size_t)(512 + d) * DM + k0) = o;
        }
        for (int it = gw; it < 32 * 64; it += ngw) {
            const int g = it >> 6, tau = it & 63;
            { float er, ei, qr, qi; ssm_apow(sp, g, lane, (float)tau, er, ei); ssm_q(sp, g, lane, qr, qi);
              scr[lane] = er * qr - ei * qi; scr[64 + lane] = er * qi + ei * qr; }
            asm volatile("s_waitcnt lgkmcnt(0)" ::: "memory");
            const int ho = lane >> 2, hq = lane & 3;
            float a0 = 0.f, a1 = 0.f, a2 = 0.f, a3 = 0.f;
#pragma unroll 16
            for (int n = 0; n < 64; ++n) {
                const float fr_ = scr[n], fi_ = scr[64 + n];
                const float cr = sp.cre[(size_t)(g * 16 + ho) * 64 + n], ci = sp.cim[(size_t)(g * 16 + ho) * 64 + n];
                const float wr_ = cr * fr_ - ci * fi_, wi_ = cr * fi_ + ci * fr_;
                const f32x4 br = *(const f32x4*)(sp.bre + (size_t)(g * 64 + n) * 16 + 4 * hq), bi = *(const f32x4*)(sp.bim + (size_t)(g * 64 + n) * 16 + 4 * hq);
                a0 += wr_ * br[0] - wi_ * bi[0]; a1 += wr_ * br[1] - wi_ * bi[1]; a2 += wr_ * br[2] - wi_ * bi[2]; a3 += wr_ * br[3] - wi_ * bi[3];
            }
            if (tau == 0) { const float dv = sp.dskip[g * 16 + ho]; const int j = ho - 4 * hq; if (j == 0) a0 += dv; if (j == 1) a1 += dv; if (j == 2) a2 += dv; if (j == 3) a3 += dv; }
            *(f32x4*)(Ktab + ((size_t)(g * 64 + tau) * 16 + ho) * 16 + 4 * hq) = (f32x4){a0, a1, a2, a3};
            asm volatile("s_waitcnt lgkmcnt(0)" ::: "memory");
        }
        for (int it = gt; it < 32 * 65 * 64; it += ngt) {
            const int n = it & 63, pg = it >> 6, pp = pg % 65, g = pg / 65;
            float er, ei, qr, qi; ssm_apow(sp, g, n, (float)pp, er, ei); ssm_q(sp, g, n, qr, qi);
            *(float2*)(EP + ((size_t)(g * 65 + pp) * 64 + n) * 2) = make_float2(er, ei);
            if (pp < 64) *(float2*)(EQ + ((size_t)(g * 64 + pp) * 64 + n) * 2) = make_float2(er * qr - ei * qi, er * qi + ei * qr);
        }
        if (!(wave & 1)) e0_rows(x, XN, RS, gw, ngw, lane);
        if (gw < 16) rms_row_to_bf16(meta + (size_t)gw * DM, nullptr, xn1m + (size_t)gw * DM, lane);
    }
    GRID_SYNC();

    int vid = blk;
    { bool even = (G % 8) == 0;
      for (unsigned j = 0; j < 16; ++j) { const unsigned cnt = xb_ld((unsigned*)(ws + WS_CTL) + XB_XCNT(j)); if (cnt != (j < 8 ? (unsigned)(G / 8) : 0u)) even = false; }
      const unsigned rk = bst[2];
      if (even && rk < (unsigned)(G / 8) && bar.x < 8u) vid = (int)(rk * 8u + bar.x); }
    vid = __builtin_amdgcn_readfirstlane(vid);
    {
        for (int it0 = gt; it0 < 32 * 256 * 128; it0 += 4 * ngt) {
            u32x4 ov[4];
#pragma unroll
            for (int u = 0; u < 4; ++u) {
                const int it = it0 + u * ngt; u32x4 o = {0u, 0u, 0u, 0u};
                const int kc = it & 127, row = (it >> 7) & 255, g = (it >> 15) & 31;
                if (it < 32 * 256 * 128 && row < 128) {
                    const int n = row & 63, part = row >> 6, s = kc >> 1, hi0 = (kc & 1) * 8;
                    const float2 f = *(const float2*)(EQ + ((size_t)(g * 64 + (63 - s)) * 64 + n) * 2);
                    const float* br = sp.bre + (size_t)(g * 64 + n) * 16 + hi0; const float* bi = sp.bim + (size_t)(g * 64 + n) * 16 + hi0;
                    const f32x4 b0 = *(const f32x4*)br, b1 = *(const f32x4*)(br + 4), c0 = *(const f32x4*)bi, c1 = *(const f32x4*)(bi + 4);
                    f32x4 v0, v1;
                    if (part == 0) { v0 = f.x * b0 - f.y * c0; v1 = f.x * b1 - f.y * c1; } else { v0 = f.x * c0 + f.y * b0; v1 = f.x * c1 + f.y * b1; }
                    o.x = cvt_pk_bf16(v0[0], v0[1]); o.y = cvt_pk_bf16(v0[2], v0[3]); o.z = cvt_pk_bf16(v1[0], v1[1]); o.w = cvt_pk_bf16(v1[2], v1[3]);
                }
                ov[u] = o;
            }
#pragma unroll
            for (int u = 0; u < 4; ++u) { const int it = it0 + u * ngt; if (it < 32 * 256 * 128) { const int kc = it & 127, row = (it >> 7) & 255, g = it >> 15; *(u32x4*)(W2 + ((size_t)(g * 256 + row) * 1024 + kc * 8)) = ov[u]; } }
        }
        for (int it0 = gt; it0 < 32 * 1024 * 144; it0 += 4 * ngt) {
            u32x4 ov[4];
#pragma unroll
            for (int u = 0; u < 4; ++u) {
                const int it = (it0 + u * ngt < 32 * 1024 * 144) ? it0 + u * ngt : it0; u32x4 o = {0u, 0u, 0u, 0u};
                const int kc = it % 144, rg = it / 144, row = rg & 1023, g = rg >> 10, t = row >> 4, ho = row & 15;
                if (kc >= 16) {
                    const int s = (kc - 16) >> 1, hi0 = (kc & 1) * 8;
                    if (s <= t) { const float* kp = Ktab + ((size_t)(g * 64 + (t - s)) * 16 + ho) * 16 + hi0; const f32x4 k0 = *(const f32x4*)kp, k1 = *(const f32x4*)(kp + 4);
                        o.x = cvt_pk_bf16(k0[0], k0[1]); o.y = cvt_pk_bf16(k0[2], k0[3]); o.z = cvt_pk_bf16(k1[0], k1[1]); o.w = cvt_pk_bf16(k1[2], k1[3]); }
                } else {
                    const int kk = kc * 8, part = kk >> 6, n0 = kk & 63;
                    const float* ep = EP + ((size_t)(g * 65 + t + 1) * 64 + n0) * 2; const float* cr = sp.cre + (size_t)(g * 16 + ho) * 64 + n0; const float* ci = sp.cim + (size_t)(g * 16 + ho) * 64 + n0;
                    float v[8];
#pragma unroll
                    for (int j = 0; j < 8; ++j) { const float er = ep[2 * j], ei = ep[2 * j + 1]; v[j] = part == 0 ? (cr[j] * er - ci[j] * ei) : -(cr[j] * ei + ci[j] * er); }
                    o.x = cvt_pk_bf16(v[0], v[1]); o.y = cvt_pk_bf16(v[2], v[3]); o.z = cvt_pk_bf16(v[4], v[5]); o.w = cvt_pk_bf16(v[6], v[7]);
                }
                ov[u] = o;
            }
#pragma unroll
            for (int u = 0; u < 4; ++u) { const int it = it0 + u * ngt; if (it < 32 * 1024 * 144) { const int kc = it % 144, rg = it / 144, row = rg & 1023, g = rg >> 10; *(u32x4*)(M1 + ((size_t)(g * 1024 + row) * KY + kc * 8)) = ov[u]; } }
        }
        for (int tile = blk; tile < FF / 16; tile += G) {
            const int n0 = tile * 16, grow = 256 * (n0 >> 7) + (n0 & 127), fr = lane & 15, fq = lane >> 4;
            const f32x4 ag = meta_tile_split(xn1m, Wgu1 + (size_t)grow * DM, DM, DM, lane, wave, (LAS f32x4*)lds);
            const f32x4 au = meta_tile_split(xn1m, Wgu1 + (size_t)(grow + 128) * DM, DM, DM, lane, wave, (LAS f32x4*)lds);
            if (wave == 0) { u32x2 w; w.x = cvt_pk_bf16(silu_f(ag[0]) * au[0], silu_f(ag[1]) * au[1]); w.y = cvt_pk_bf16(silu_f(ag[2]) * au[2], silu_f(ag[3]) * au[3]);
                *(u32x2*)(Gm + (size_t)fr * FF + n0 + 4 * fq) = w; }
        }
        Gemm gm{XN, Wgu1, DM, DM, DM, 0, 0}; StaticOrder S; S.init(MTOK, 2 * FF, G, vid); EpiSwiGLU E{Gbuf, RS};
        gemm_phase(lds, gm, S, E);
    }
    GRID_SYNC();

    {
        for (int tile = blk; tile < DM / 16; tile += G) { const int n0 = tile * 16, fr = lane & 15, fq = lane >> 4; const f32x4 a = meta_tile_split(Gm, Wd1 + (size_t)n0 * FF, FF, FF, lane, wave, (LAS f32x4*)lds); if (wave == 0) *(f32x4*)(f1m + (size_t)fr * DM + n0 + 4 * fq) = a; }
        Gemm gm{Gbuf, Wd1, FF, FF, FF, 0, 0}; StaticOrder S; S.init(MTOK, DM, G, vid); EpiRowSsq E{Fb, SSQ};
        gemm_phase(lds, gm, S, E);
    }
    GRID_SYNC();

    {
        resid_rows<true, true, true>(XN, Fb, SSQ, 0.5f, p.in[3], Hb, RS, gw, ngw, lane);
        if (gw < 16) {
            const f32x4* hr = (const f32x4*)(meta + (size_t)gw * DM) + lane; const f32x4* fr4 = (const f32x4*)(f1m + (size_t)gw * DM) + lane;
            f32x4 v[4], f[4]; float s = 0.f;
#pragma unroll
            for (int j = 0; j < 4; ++j) { v[j] = hr[64 * j]; f[j] = fr4[64 * j]; s += (f[j][0] * f[j][0] + f[j][1] * f[j][1]) + (f[j][2] * f[j][2] + f[j][3] * f[j][3]); }
            const float r1 = 0.5f * rsq(wave_sum(s) * (1.f / DM) + EPS); float s2 = 0.f;
#pragma unroll
            for (int j = 0; j < 4; ++j) { const f32x4 gp = ((const f32x4*)p.in[3])[lane + 64 * j]; v[j] = v[j] + r1 * f[j] * gp; s2 += (v[j][0] * v[j][0] + v[j][1] * v[j][1]) + (v[j][2] * v[j][2] + v[j][3] * v[j][3]); }
            const float r2 = rsq(wave_sum(s2) * (1.f / DM) + EPS);
            u32x2* o = (u32x2*)(xn2m + (size_t)gw * DM) + lane;
#pragma unroll
            for (int j = 0; j < 4; ++j) { u32x2 w; w.x = cvt_pk_bf16(v[j][0] * r2, v[j][1] * r2); w.y = cvt_pk_bf16(v[j][2] * r2, v[j][3] * r2); o[64 * j] = w; }
        }
    }
    GRID_SYNC();

    {
        for (int tile = blk; tile < DM / 16; tile += G) { const int n0 = tile * 16, fr = lane & 15, fq = lane >> 4; const f32x4 a = meta_tile_split(xn2m, Win + (size_t)n0 * DM, DM, DM, lane, wave, (LAS f32x4*)lds); if (wave == 0) { *(f32x4*)(projm + (size_t)fr * DM + n0 + 4 * fq) = a;
            if (n0 >= 512) { u32x2 w; w.x = cvt_pk_bf16(a[0], a[1]); w.y = cvt_pk_bf16(a[2], a[3]);
                for (int b = 0; b < 8; ++b) *(u32x2*)(V + ((size_t)b * 8208 + fr) * 512 + (n0 - 512) + 4 * fq) = w; } } }
        Gemm gm{Hb, Win, DM, DM, DM, 0, 0}; StaticOrder S; S.init(MTOK, DM, G, vid); EpiProj E{UG, V, RS};
        gemm_phase(lds, gm, S, E);
    }
    GRID_SYNC();

    {
        Gemm gm{UG, W2, KY, 1024, 512, (size_t)NCHUNK * KY * 2, (size_t)256 * 1024 * 2}; OrderS S{G, vid}; EpiS E{Sb};
        gemm_phase(lds, gm, S, E);
    }
    GRID_SYNC();

    if (wave == 0) {
        for (int it = blk; it < 256; it += G) {
            const int b = it >> 5, g = it & 31, n = lane;
            float ar, ai, qr, qi, a64r, a64i; ssm_apow(sp, g, n, 1.0f, ar, ai); ssm_q(sp, g, n, qr, qi); ssm_apow(sp, g, n, 64.0f, a64r, a64i);
            const float* br = sp.bre + (size_t)(g * 64 + n) * 16; const float* bi = sp.bim + (size_t)(g * 64 + n) * 16;
            float xr = 0.f, xi = 0.f;
            for (int t = 0; t < 16; ++t) {
                const float* up = projm + (size_t)t * DM + g * 16; float sr = 0.f, si = 0.f;
#pragma unroll
                for (int h = 0; h < 16; ++h) { const float uv = up[h]; sr += br[h] * uv; si += bi[h] * uv; }
                const float bur = qr * sr - qi * si, bui = qr * si + qi * sr;
                const float nxr = ar * xr - ai * xi + bur, nxi = ar * xi + ai * xr + bui; xr = nxr; xi = nxi;
            }
            const float* sp0 = Sb + ((size_t)g * NCHUNK + b * 128) * 128 + n; bf16_t* xo = UG + ((size_t)g * NCHUNK + b * 128) * KY + n;
            for (int c0 = 0; c0 < 128; c0 += 16) {
                float svr[16], svi[16];
#pragma unroll
                for (int u = 0; u < 16; ++u) { const float* q0 = sp0 + (size_t)(c0 + u) * 128; const float* q1 = q0 + (size_t)32 * NCHUNK * 128; svr[u] = q0[0] + q1[0]; svi[u] = q0[64] + q1[64]; }
#pragma unroll
                for (int u = 0; u < 16; ++u) {
                    const unsigned pk = cvt_pk_bf16(xr, xi);
                    xo[(size_t)(c0 + u) * KY] = (bf16_t)(pk & 0xffff); xo[(size_t)(c0 + u) * KY + 64] = (bf16_t)(pk >> 16);
                    const float nxr = a64r * xr - a64i * xi + svr[u], nxi = a64r * xi + a64i * xr + svi[u]; xr = nxr; xi = nxi;
                }
            }
        }
    }
    GRID_SYNC();

    {
        Gemm gm{UG, M1, KY, KY, KY, (size_t)NCHUNK * KY * 2, (size_t)1024 * KY * 2}; OrderY S{G, vid}; EpiY E{sp.wglu, XN, SSQS};
        gemm_phase(lds, gm, S, E);

    }
    GRID_SYNC();

    {
        const int wl = 2 << (lane >> 4); const float winv = 1.0f / (float)wl;
        const int rpw = (MTOK + ngw - 1) / ngw, rbeg = gw * rpw, rend = (rbeg + rpw < MTOK) ? rbeg + rpw : MTOK;
        for (int r0 = rbeg; r0 < rend; r0 += 4) {
            const bool fast = (r0 + 3 < rend);
            if (fast) {
                float sq[4]; u32x4 qv[19];
#pragma unroll
                for (int t = 0; t < 4; ++t) { const int r = r0 + t;
                    sq[t] = SSQS[((size_t)((lane & 31) * 4 + ((r & 63) >> 4)) * NCHUNK + (r >> 6)) * 16 + (r & 15)]; }
                const int vr3 = r0 + 3 + 16 * (((r0 + 3) >> 13) + 1);
#pragma unroll
                for (int k = 0; k < 19; ++k) qv[k] = (k < wl + 3) ? *(const u32x4*)(V + (size_t)(vr3 - k) * 512 + 8 * lane) : (u32x4){0u, 0u, 0u, 0u};
#pragma unroll
                for (int t = 0; t < 4; ++t) { const int r = r0 + t;
                    const float irs = sqrtf(wave_sum(sq[t]) * 0.5f * (1.f / 512) + EPS);
                    if (lane == 0) RS[r] = 1.0f / irs;
                    float a[8];
#pragma unroll
                    for (int q = 0; q < 8; ++q) a[q] = 0.f;
#pragma unroll
                    for (int d = 0; d < 16; ++d) { const u32x4 q = qv[d + 3 - t]; const float msk = (d < wl) ? 1.0f : 0.0f;
                        a[0] += msk * bf_lo(q.x); a[1] += msk * bf_hi(q.x); a[2] += msk * bf_lo(q.y); a[3] += msk * bf_hi(q.y); a[4] += msk * bf_lo(q.z); a[5] += msk * bf_hi(q.z); a[6] += msk * bf_lo(q.w); a[7] += msk * bf_hi(q.w); }
                    const u32x4 c = qv[3 - t];
                    const float cur[8] = {bf_lo(c.x), bf_hi(c.x), bf_lo(c.y), bf_hi(c.y), bf_lo(c.z), bf_hi(c.z), bf_lo(c.w), bf_hi(c.w)};
                    float ss = 0.f;
#pragma unroll
                    for (int q = 0; q < 8; ++q) { a[q] = a[q] * winv - cur[q]; ss += a[q] * a[q]; }
                    const float rp = rsq(wave_sum(ss) * (1.f / 512) + EPS);
                    const float sc = rp * irs;
                    u32x4 w2; w2.x = cvt_pk_bf16(a[0] * sc, a[1] * sc); w2.y = cvt_pk_bf16(a[2] * sc, a[3] * sc); w2.z = cvt_pk_bf16(a[4] * sc, a[5] * sc); w2.w = cvt_pk_bf16(a[6] * sc, a[7] * sc);
                    *(u32x4*)(XN + (size_t)r * DM + 512 + 8 * lane) = w2; }
            } else {
                for (int tt = 0; tt < 4; ++tt) { const int r = r0 + tt; if (r >= rend) break;
        const int tl = r & 8191;
        const float irs = sqrtf(wave_sum(SSQS[((size_t)((lane & 31) * 4 + ((r & 63) >> 4)) * NCHUNK + (r >> 6)) * 16 + (r & 15)]) * 0.5f * (1.f / 512) + EPS);
        if (lane == 0) RS[r] = 1.0f / irs;
        {
            const int wlen = 2 << (lane >> 4);
            float a[8], cur[8];
#pragma unroll
            for (int j = 0; j < 8; ++j) { a[j] = 0.f; cur[j] = 0.f; }
            for (int d = 0; d < 16; ++d) {
                if (d < wlen) {
                    float v[8];
                    { const u32x4 q = *(const u32x4*)(V + (size_t)(r + 16 * ((r >> 13) + 1) - d) * 512 + 8 * lane);
                        v[0] = bf_lo(q.x); v[1] = bf_hi(q.x); v[2] = bf_lo(q.y); v[3] = bf_hi(q.y); v[4] = bf_lo(q.z); v[5] = bf_hi(q.z); v[6] = bf_lo(q.w); v[7] = bf_hi(q.w); }
#pragma unroll
                    for (int j = 0; j < 8; ++j) { a[j] += v[j]; if (d == 0) cur[j] = v[j]; }
                }
            }
            const float inv = 1.0f / (float)wlen; float s = 0.f;
#pragma unroll
            for (int j = 0; j < 8; ++j) { a[j] = a[j] * inv - cur[j]; s += a[j] * a[j]; }
            const float rp = rsq(wave_sum(s) * (1.f / 512) + EPS);
            const float sc = rp * irs;
            u32x4 w; w.x = cvt_pk_bf16(a[0] * sc, a[1] * sc); w.y = cvt_pk_bf16(a[2] * sc, a[3] * sc); w.z = cvt_pk_bf16(a[4] * sc, a[5] * sc); w.w = cvt_pk_bf16(a[6] * sc, a[7] * sc);
            *(u32x4*)(XN + (size_t)r * DM + 512 + 8 * lane) = w;
        }
                    }
            }
        }
    }
    GRID_SYNC();

    {
        Gemm gm{XN, Wout, DM, DM, DM, 0, 0}; StaticOrder S; S.init(MTOK, DM, G, vid); EpiRowSsqScaled E{Fb, SSQ, RS};
        gemm_phase(lds, gm, S, E);
    }
    GRID_SYNC();

    resid_rows<true, true, true>(Hb, Fb, SSQ, 1.0f, p.in[8], Hb, RS, gw, ngw, lane);
    GRID_SYNC();

    {
        Gemm gm{Hb, Wgu2, DM, DM, DM, 0, 0}; StaticOrder S; S.init(MTOK, 2 * FF, G, vid); EpiSwiGLU E{Gbuf, RS};
        gemm_phase(lds, gm, S, E);
    }
    GRID_SYNC();
    {
        Gemm gm{Gbuf, Wd2, FF, FF, FF, 0, 0}; StaticOrder S; S.init(MTOK, DM, G, vid); EpiRowSsq E{Fb, SSQ};
        gemm_phase(lds, gm, S, E);
    }
    GRID_SYNC();

    resid_rows<false, true, false>(Hb, Fb, SSQ, 0.5f, p.in[25], out, nullptr, gw, ngw, lane);
}

extern "C" void kernel_launch(void* const* d_in, const int* in_sizes, int n_in, void* d_out, int out_size, void* d_ws, size_t ws_size, hipStream_t stream) {
    constexpr size_t kDynLds = STAGE_BYTES + 4096;
    static int grid_blocks = 0;
    if (!grid_blocks) {
        int dev = 0, cus = 0, per_cu = 0;
        hipGetDevice(&dev);
        hipDeviceGetAttribute(&cus, hipDeviceAttributeMultiprocessorCount, dev);
        hipFuncSetAttribute((const void*)hymba_fwd, hipFuncAttributeMaxDynamicSharedMemorySize, (int)kDynLds);
        hipOccupancyMaxActiveBlocksPerMultiprocessor(&per_cu, (const void*)hymba_fwd, NTHREADS, kDynLds);
        if (per_cu < 1) { fprintf(stderr, "occupancy query returned %d\n", per_cu); per_cu = 1; }
        grid_blocks = cus;
        if (ws_size < WS_END) fprintf(stderr, "workspace too small: %zu < %zu\n", ws_size, (size_t)WS_END);
    }
    (void)hipMemsetAsync((char*)d_ws + WS_CTL, 0, CTL_ZERO_BYTES, stream);
    Params p{};
    for (int i = 0; i < 29; ++i) p.in[i] = (const float*)d_in[i];
    p.out = (float*)d_out; p.ws = (unsigned char*)d_ws;
    void* args[] = {&p};
    hipError_t e = hipLaunchCooperativeKernel((const void*)hymba_fwd, dim3(grid_blocks), dim3(NTHREADS), args, kDynLds, stream);
    if (e != hipSuccess) fprintf(stderr, "cooperative launch failed: %s (grid %d)\n", hipGetErrorString(e), grid_blocks);
}
```

```cpp
#include <hip/hip_runtime.h>
#include <hip/hip_cooperative_groups.h>
#include <cstdio>
namespace cg = cooperative_groups;

#define LAS __attribute__((address_space(3)))
typedef unsigned short bf16_t;
typedef short bf16x8 __attribute__((ext_vector_type(8)));
typedef short bf16x4 __attribute__((ext_vector_type(4)));
typedef float f32x4 __attribute__((ext_vector_type(4)));
typedef unsigned u32x4 __attribute__((ext_vector_type(4)));
typedef unsigned u32x2 __attribute__((ext_vector_type(2)));

constexpr int MTOK = 65536;
constexpr int DM = 1024, FF = 2816, NCHUNK = 1024, KY = 1152;
constexpr float EPS = 1e-6f;
constexpr int NTHREADS = 512, NWAVES = 8;

constexpr size_t al256(size_t x) { return (x + 255) & ~(size_t)255; }
constexpr size_t WS_CTL   = 0;
constexpr size_t WS_WGU1  = 65536;
constexpr size_t SZ_WGU   = (size_t)2 * FF * DM * 2;
constexpr size_t WS_WD1   = WS_WGU1 + SZ_WGU;
constexpr size_t SZ_WD    = (size_t)DM * FF * 2;
constexpr size_t WS_WGU2  = WS_WD1 + SZ_WD;
constexpr size_t WS_WD2   = WS_WGU2 + SZ_WGU;
constexpr size_t WS_WIN   = WS_WD2 + SZ_WD;
constexpr size_t WS_WOUT  = WS_WIN + (size_t)DM * DM * 2;
constexpr size_t WS_M1    = WS_WOUT + (size_t)DM * DM * 2;
constexpr size_t SZ_M1    = (size_t)32 * 1024 * KY * 2;
constexpr size_t WS_W2    = WS_M1 + SZ_M1;
constexpr size_t SZ_W2    = (size_t)32 * 256 * 1024 * 2;
constexpr size_t WS_KTAB  = WS_W2 + SZ_W2;
constexpr size_t SZ_KTAB  = (size_t)32 * 64 * 256 * 4;
constexpr size_t WS_XN1M  = WS_KTAB + SZ_KTAB;
constexpr size_t WS_GM    = WS_XN1M + 16 * DM * 2;
constexpr size_t WS_F1M   = al256(WS_GM + 16 * FF * 2);
constexpr size_t WS_XN2M  = WS_F1M + 16 * DM * 4;
constexpr size_t WS_PROJM = WS_XN2M + 16 * DM * 2;
constexpr size_t WS_XN    = WS_PROJM + 16 * DM * 4;
constexpr size_t WS_F     = WS_XN + (size_t)MTOK * DM * 2;
constexpr size_t WS_SSQ   = WS_F + (size_t)MTOK * DM * 2;
constexpr size_t WS_GBUF  = WS_SSQ + (size_t)MTOK * 16 * 4;
constexpr size_t SZ_GBUF  = (size_t)MTOK * FF * 2;
constexpr size_t WS_UG    = WS_GBUF;
constexpr size_t SZ_UG    = (size_t)32 * 1024 * KY * 2;
constexpr size_t WS_V     = WS_UG + SZ_UG;
constexpr int VROWS = 8 * (8192 + 16);
constexpr size_t WS_S     = WS_V + (size_t)VROWS * 512 * 2;
constexpr size_t WS_END0  = WS_GBUF + SZ_GBUF;
constexpr size_t WS_OS    = WS_END0;
constexpr size_t WS_SSQS  = WS_OS + (size_t)MTOK * 512 * 2;
constexpr size_t WS_H     = WS_SSQS + (size_t)MTOK * 32 * 4;
constexpr size_t WS_EQ    = WS_H + (size_t)MTOK * DM * 2;
constexpr size_t WS_EP    = WS_EQ + (size_t)32 * 64 * 64 * 8;
constexpr size_t WS_RS    = WS_EP + (size_t)32 * 65 * 64 * 8;
constexpr size_t WS_END   = WS_RS + (size_t)MTOK * 4;
static_assert(WS_S + (size_t)2 * 32 * 1024 * 128 * 4 <= WS_END0, "alias region overflow");

struct Params { const float* in[29]; float* out; unsigned char* ws; };

typedef float f32x2c __attribute__((ext_vector_type(2)));
typedef __bf16 bf16x2c __attribute__((ext_vector_type(2)));
__device__ __forceinline__ unsigned cvt_pk_bf16(float lo, float hi) { const f32x2c v = {lo, hi}; const bf16x2c r = __builtin_convertvector(v, bf16x2c); return __builtin_bit_cast(unsigned, r); }
__device__ __forceinline__ float bf_lo(unsigned w) { return __uint_as_float(w << 16); }
__device__ __forceinline__ float bf_hi(unsigned w) { return __uint_as_float(w & 0xffff0000u); }
__device__ __forceinline__ float wave_sum(float v) {
#pragma unroll
    for (int o = 1; o < 64; o <<= 1) v += __shfl_xor(v, o);
    return v;
}
__device__ __forceinline__ float fast_sigmoid(float z) { return __builtin_amdgcn_rcpf(1.0f + __builtin_amdgcn_exp2f(-1.4426950408889634f * z)); }
__device__ __forceinline__ float silu_f(float x) { return x * fast_sigmoid(x); }
__device__ __forceinline__ float gelu_tanh_f(float x) { const float z = 0.7978845608028654f * (x + 0.044715f * x * x * x); return x * fast_sigmoid(2.0f * z); }
__device__ __forceinline__ float rsq(float x) { return 1.0f / sqrtf(x); }

struct SsmP { const float *lre, *lim, *logdt, *bre, *bim, *cre, *cim, *dskip, *wglu; };
__device__ __forceinline__ void ssm_apow(const SsmP& P, int g, int n, float p, float& er, float& ei) {
    const float dt = expf(P.logdt[g]); const float lr = P.lre[g * 64 + n], li = P.lim[g * 64 + n];
    const float mag = expf(lr * dt * p);
    double turns = (double)li * (double)dt * (double)p * 0.15915494309189535;
    turns -= rint(turns);
    const float tf = (float)turns;
    er = mag * __builtin_amdgcn_cosf(tf); ei = mag * __builtin_amdgcn_sinf(tf);
}
__device__ __forceinline__ void ssm_q(const SsmP& P, int g, int n, float& qr, float& qi) {
    const float dt = expf(P.logdt[g]); const float lr = P.lre[g * 64 + n], li = P.lim[g * 64 + n];
    const float em1 = expm1f(lr * dt), decay = 1.0f + em1;
    double turns = (double)li * (double)dt * 0.15915494309189535;
    double t1 = turns - rint(turns); double t2 = turns * 0.5; t2 -= rint(t2);
    const float c = __builtin_amdgcn_cosf((float)t1), s = __builtin_amdgcn_sinf((float)t1), sh = __builtin_amdgcn_sinf((float)t2);
    const float ai = decay * s;
    const float nr = em1 * c - 2.0f * sh * sh;
    const float den = lr * lr + li * li;
    qr = (nr * lr + ai * li) / den; qi = (ai * lr - nr * li) / den;
}

constexpr int BM = 256, BK = 64, HALF = 128, HTB = HALF * BK * 2, STAGE_BYTES = 8 * HTB, NXCD = 8, WGM = 8;
__device__ __forceinline__ int lds_byte(int r, int c) { const int st = (r >> 4) * 2 + (c >> 5), rr = r & 15, cc = c & 31, ob = rr * 64 + cc * 2; return st * 1024 + (ob ^ (((ob >> 9) & 1) << 5)); }
__device__ __forceinline__ void stage_rc(int b, int& R, int& C) { const int st = b / 1024, sb = b % 1024, swz = sb ^ (((sb >> 9) & 1) << 5); R = (st >> 1) * 16 + swz / 64; C = (st & 1) * 32 + (swz % 64) / 2; }
__device__ __forceinline__ int perm32(int rho) { const int n = rho >> 4, i = rho & 15; return 8 * (i >> 2) + 4 * n + (i & 3); }

struct Unit { int pm, pn, g, kofs, kofsA, nt; };
struct Gemm { const bf16_t* A; const bf16_t* Bt; int lda, ldb, K; size_t gsA, gsB; };

struct StaticOrder {
    int nM, nN, nwg, G, c;
    __device__ void init(int M, int N, int G_, int c_) { nM = M / BM; nN = N / BM; nwg = nM * nN; G = G_; c = c_; }
    __device__ bool next(int i, Unit& u) const {
        const long L = (long)i * G + c; if (L >= nwg) return false;
        int wgid = (int)L; { const int q = nwg / NXCD, r = nwg % NXCD, xcd = wgid % NXCD, off = wgid / NXCD; wgid = (xcd < r ? xcd * (q + 1) : r * (q + 1) + (xcd - r) * q) + off; }
        const int nig = WGM * nN, gid = wgid / nig, fm = gid * WGM, gsz = (nM - fm) < WGM ? (nM - fm) : WGM;
        u.pm = fm + ((wgid % nig) % gsz); u.pn = (wgid % nig) / gsz; u.g = 0; u.kofs = 0; u.kofsA = 0; u.nt = 0; return true;
    }
};
struct OrderS {
    int G, c;
    __device__ bool next(int i, Unit& u) const { const int L = i * G + c; if (L >= 256) return false; u.g = L >> 3; u.pm = (L >> 1) & 3; u.pn = 0; u.kofs = (L & 1) * 1024; u.kofsA = 256; u.nt = 0; return true; }
};
struct OrderY {
    int G, c;
    __device__ bool next(int i, Unit& u) const { const int L = i * G + c; if (L >= 512) return false; const int l = L & 255;
        u.g = l >> 3; u.pm = (l >> 1) & 3; u.pn = (L < 256) ? (l & 1) : 3 - (l & 1); u.kofs = 0; u.kofsA = 0; u.nt = 2 + 4 * (u.pn + 1); return true; }
};

typedef f32x4 Acc[2][2][4][2];

struct EpiSwiGLU {
    static constexpr bool PERM = true;
    bf16_t* G; const float* RS;
    static constexpr bool USES_RS = true;
    __device__ __forceinline__ void operator()(const Acc& acc, const Unit& u, int wr, int wc, int fr, int fq, const LAS float* rsl) const {
        const int row0 = u.pm * BM + wr * 64 + fr, col0 = u.pn * 128 + wc * 32 + 8 * fq;
        float rsv[2][4];
#pragma unroll
        for (int ai = 0; ai < 2; ++ai)
#pragma unroll
            for (int m = 0; m < 4; ++m) rsv[ai][m] = rsl[ai * HALF + wr * 64 + m * 16 + fr];
#pragma unroll
        for (int ai = 0; ai < 2; ++ai)
#pragma unroll
            for (int m = 0; m < 4; ++m) {
                bf16_t* rowp = G + (size_t)(row0 + ai * HALF + m * 16) * FF + col0; const float rs = rsv[ai][m];
                const f32x4 g0 = acc[ai][0][m][0] * rs, g1 = acc[ai][0][m][1] * rs, u0 = acc[ai][1][m][0] * rs, u1 = acc[ai][1][m][1] * rs;
                u32x4 w;
                w.x = cvt_pk_bf16(silu_f(g0[0]) * u0[0], silu_f(g0[1]) * u0[1]); w.y = cvt_pk_bf16(silu_f(g0[2]) * u0[2], silu_f(g0[3]) * u0[3]);
                w.z = cvt_pk_bf16(silu_f(g1[0]) * u1[0], silu_f(g1[1]) * u1[1]); w.w = cvt_pk_bf16(silu_f(g1[2]) * u1[2], silu_f(g1[3]) * u1[3]);
                *(u32x4*)rowp = w;
            }
    }
};
template <bool SCALED> struct EpiRowSsqT {
    static constexpr bool PERM = true;
    bf16_t* F; float* SSQ; const float* RS = nullptr;
    static constexpr bool USES_RS = SCALED;
    __device__ __forceinline__ void operator()(const Acc& acc, const Unit& u, int wr, int wc, int fr, int fq, const LAS float* rsl) const {
        const int row0 = u.pm * BM + wr * 64 + fr, col0 = u.pn * BM + wc * 32 + 8 * fq;
        float rsv[2][4];
#pragma unroll
        for (int ai = 0; ai < 2; ++ai)
#pragma unroll
            for (int m = 0; m < 4; ++m) rsv[ai][m] = SCALED ? rsl[ai * HALF + wr * 64 + m * 16 + fr] : 1.0f;
#pragma unroll
        for (int ai = 0; ai < 2; ++ai)
#pragma unroll
            for (int m = 0; m < 4; ++m) {
                const int row = row0 + ai * HALF + m * 16;
                bf16_t* rowp = F + (size_t)row * DM + col0; float s = 0.f;
#pragma unroll
                for (int bj = 0; bj < 2; ++bj) {
                    const f32x4 v0 = acc[ai][bj][m][0] * rsv[ai][m], v1 = acc[ai][bj][m][1] * rsv[ai][m];
                    s += (v0[0] * v0[0] + v0[1] * v0[1]) + (v0[2] * v0[2] + v0[3] * v0[3]) + (v1[0] * v1[0] + v1[1] * v1[1]) + (v1[2] * v1[2] + v1[3] * v1[3]);
                    u32x4 w; w.x = cvt_pk_bf16(v0[0], v0[1]); w.y = cvt_pk_bf16(v0[2], v0[3]); w.z = cvt_pk_bf16(v1[0], v1[1]); w.w = cvt_pk_bf16(v1[2], v1[3]);
                    *(u32x4*)(rowp + bj * HALF) = w;
                }
                s += __shfl_xor(s, 16); s += __shfl_xor(s, 32);
                if (fq == 0) SSQ[(size_t)row * 16 + u.pn * 4 + wc] = s;
            }
    }
};
typedef EpiRowSsqT<false> EpiRowSsq; typedef EpiRowSsqT<true> EpiRowSsqScaled;
struct EpiProj {
    static constexpr bool PERM = true;
    bf16_t* UG; bf16_t* V; const float* RS;
    static constexpr bool USES_RS = true;
    __device__ __forceinline__ void operator()(const Acc& acc, const Unit& u, int wr, int wc, int fr, int fq, const LAS float* rsl) const {
        const int row0 = u.pm * BM + wr * 64 + fr;
        float rsv[2][4];
#pragma unroll
        for (int ai = 0; ai < 2; ++ai)
#pragma unroll
            for (int m = 0; m < 4; ++m) rsv[ai][m] = rsl[ai * HALF + wr * 64 + m * 16 + fr];
#pragma unroll
        for (int ai = 0; ai < 2; ++ai)
#pragma unroll
            for (int m = 0; m < 4; ++m) {
                const int row = row0 + ai * HALF + m * 16; const float rs = rsv[ai][m];
#pragma unroll
                for (int bj = 0; bj < 2; ++bj) {
                    const int c0 = u.pn * BM + bj * HALF + wc * 32 + 8 * fq;
                    const f32x4 v0 = acc[ai][bj][m][0] * rs, v1 = acc[ai][bj][m][1] * rs;
                    u32x4 w; w.x = cvt_pk_bf16(v0[0], v0[1]); w.y = cvt_pk_bf16(v0[2], v0[3]); w.z = cvt_pk_bf16(v1[0], v1[1]); w.w = cvt_pk_bf16(v1[2], v1[3]);
                    bf16_t* dst;
                    if (u.pn < 2) { const int g = c0 >> 4, ch0 = c0 & 15, chunk = row >> 6, t = row & 63; dst = UG + ((size_t)(g * NCHUNK + chunk) * KY + 128 + t * 16 + ch0); }
                    else dst = V + (size_t)(row + 16 * ((row >> 13) + 1)) * 512 + (c0 - 512);
                    *(u32x4*)dst = w;
                }
            }
    }
};
struct EpiS {
    static constexpr bool PERM = false;
    float* S;
    static constexpr bool USES_RS = false; const float* RS = nullptr;
    __device__ __forceinline__ void operator()(const Acc& acc, const Unit& u, int wr, int wc, int fr, int fq, const LAS float* rsl) const {
        const int row0 = u.pm * BM + wr * 64 + fr, col0 = wc * 32 + 4 * fq;
#pragma unroll
        for (int ai = 0; ai < 2; ++ai)
#pragma unroll
            for (int m = 0; m < 4; ++m) {
                float* rowp = S + (u.kofs ? (size_t)32 * NCHUNK * 128 : (size_t)0) + ((size_t)u.g * NCHUNK + row0 + ai * HALF + m * 16) * 128 + col0;
#pragma unroll
                for (int n = 0; n < 2; ++n) *(f32x4*)(rowp + n * 16) = acc[ai][0][m][n];
            }
    }
};
struct EpiY {
    static constexpr bool PERM = false;
    const float* wglu; bf16_t* OS; float* SSQS;
    static constexpr bool USES_RS = false; const float* RS = nullptr;
    __device__ __forceinline__ void operator()(const Acc& acc, const Unit& u, int wr, int wc, int fr, int fq, const LAS float* rsl) const {
        const float* wp = wglu + ((size_t)u.g * 16 + 4 * fq) * 32 + fr;
        bf16x4 wv, wg;
        { float wl[8];
#pragma unroll
          for (int q = 0; q < 8; ++q) wl[q] = wp[16 * q];
          const unsigned a0 = cvt_pk_bf16(wl[0], wl[2]), a1 = cvt_pk_bf16(wl[4], wl[6]); wv[0] = (short)(a0 & 0xffff); wv[1] = (short)(a0 >> 16); wv[2] = (short)(a1 & 0xffff); wv[3] = (short)(a1 >> 16);
          const unsigned b0 = cvt_pk_bf16(wl[1], wl[3]), b1 = cvt_pk_bf16(wl[5], wl[7]); wg[0] = (short)(b0 & 0xffff); wg[1] = (short)(b0 >> 16); wg[2] = (short)(b1 & 0xffff); wg[3] = (short)(b1 >> 16); }
#pragma unroll
        for (int ai = 0; ai < 2; ++ai)
#pragma unroll
            for (int m = 0; m < 4; ++m) {
                const int chunk = u.pm * BM + ai * HALF + wr * 64 + m * 16 + fr;
#pragma unroll
                for (int bj = 0; bj < 2; ++bj)
#pragma unroll
                    for (int n = 0; n < 2; ++n) {
                        const f32x4 a = acc[ai][bj][m][n];
                        const unsigned p0 = cvt_pk_bf16(gelu_tanh_f(a[0]), gelu_tanh_f(a[1])), p1 = cvt_pk_bf16(gelu_tanh_f(a[2]), gelu_tanh_f(a[3]));
                        bf16x4 gy; gy[0] = (short)(p0 & 0xffff); gy[1] = (short)(p0 >> 16); gy[2] = (short)(p1 & 0xffff); gy[3] = (short)(p1 >> 16);
                        const f32x4 z0 = {0.f, 0.f, 0.f, 0.f};
                        const f32x4 zv = __builtin_amdgcn_mfma_f32_16x16x16bf16_1k(wv, gy, z0, 0, 0, 0);
                        const f32x4 zg = __builtin_amdgcn_mfma_f32_16x16x16bf16_1k(wg, gy, z0, 0, 0, 0);
                        const float o0 = zv[0] * fast_sigmoid(zg[0]), o1 = zv[1] * fast_sigmoid(zg[1]), o2 = zv[2] * fast_sigmoid(zg[2]), o3 = zv[3] * fast_sigmoid(zg[3]);
                        const int t = u.pn * 16 + bj * 8 + wc * 2 + n; const size_t token = (size_t)chunk * 64 + t;
                        u32x2 w; w.x = cvt_pk_bf16(o0, o1); w.y = cvt_pk_bf16(o2, o3);
                        *(u32x2*)(OS + token * DM + u.g * 16 + 4 * fq) = w;
                        float s = (o0 * o0 + o1 * o1) + (o2 * o2 + o3 * o3);
                        s += __shfl_xor(s, 16); s += __shfl_xor(s, 32);
                        if (fq == 0) SSQS[((size_t)(u.g * 4 + u.pn) * NCHUNK + chunk) * 16 + (t & 15)] = s;
                    }
            }
    }
};

template <class Epi, class Sched>
__device__ __forceinline__ void gemm_phase(LAS unsigned char* lds, const Gemm g, const Sched& S, const Epi& E) {
    int tid = threadIdx.x; asm volatile("" : "+v"(tid));
    const int wid = __builtin_amdgcn_readfirstlane(tid >> 6), lane = tid & 63, wr = wid >> 2, wc = wid & 3, fr = lane & 15, fq = lane >> 4;
    const int ntK = g.K / BK;
    unsigned voffA[2], voffB[2];
#pragma unroll
    for (int i = 0; i < 2; ++i) { int R, C; stage_rc(tid * 16 + i * 8192, R, C); const int Rb = Epi::PERM ? ((R & ~31) + perm32(R & 31)) : R;
        voffA[i] = (unsigned)(R * g.lda + C) * 2u; voffB[i] = (unsigned)(Rb * g.ldb + C) * 2u; }
    const size_t kstep = (size_t)(BK * 2);
    const size_t hstepA = (size_t)HALF * g.lda * 2, hstepB = (size_t)HALF * g.ldb * 2;
    const size_t tstepA = 2 * hstepA, tstepB = 2 * hstepB;
    const unsigned ldsw = (unsigned)wid * 1024u;
    const int aoff = lds_byte(wr * 64 + fr, fq * 8), boff = lds_byte(wc * 32 + fr, fq * 8);
#define PG8_SA(b, h) (((b) * 2 + (h)) * HTB)
#define PG8_SB(b, h) ((4 + (b) * 2 + (h)) * HTB)
#define PG8_STAGE(bufoff, gbase, voff) do { _Pragma("unroll") for (int _i = 0; _i < 2; ++_i) \
        __builtin_amdgcn_global_load_lds((const unsigned*)((const char*)(gbase) + (voff)[_i]), (LAS unsigned*)(lds + (bufoff) + ldsw + _i * 8192), 16, 0, 0); } while (0)
#define PG8_LDA(dst, b, h) do { _Pragma("unroll") for (int m = 0; m < 4; ++m) _Pragma("unroll") for (int k = 0; k < 2; ++k) dst[m][k] = *(const LAS bf16x8*)(lds + PG8_SA(b, h) + aoff + m * 2048 + k * 1024); } while (0)
#define PG8_LDB(dst, b, h) do { _Pragma("unroll") for (int n = 0; n < 2; ++n) _Pragma("unroll") for (int k = 0; k < 2; ++k) dst[n][k] = *(const LAS bf16x8*)(lds + PG8_SB(b, h) + boff + n * 2048 + k * 1024); } while (0)
#define PG8_MMA(ai, bj, At, Bt) do { __builtin_amdgcn_s_setprio(1); _Pragma("unroll") for (int m = 0; m < 4; ++m) _Pragma("unroll") for (int n = 0; n < 2; ++n) _Pragma("unroll") for (int k = 0; k < 2; ++k) \
        acc[ai][bj][m][n] = __builtin_amdgcn_mfma_f32_16x16x32_bf16(Bt[n][k], At[m][k], acc[ai][bj][m][n], 0, 0, 0); __builtin_amdgcn_s_setprio(0); } while (0)
#define PG8_WAIT_V(n) asm volatile("s_waitcnt vmcnt(" #n ")" ::: "memory")
#define PG8_WAIT_L(n) asm volatile("s_waitcnt lgkmcnt(" #n ")" ::: "memory")
#define PG8_BAR __builtin_amdgcn_s_barrier()
#define PG8_SCHED __builtin_amdgcn_sched_barrier(0)
    Unit cur, nxt; int ui = 0;
    if (!S.next(0, cur)) return;
    Acc acc;
#pragma unroll
    for (int a = 0; a < 2; ++a)
#pragma unroll
        for (int b = 0; b < 2; ++b)
#pragma unroll
            for (int m = 0; m < 4; ++m)
#pragma unroll
                for (int n = 0; n < 2; ++n) acc[a][b][m][n] = (f32x4){0.f, 0.f, 0.f, 0.f};
    bf16x8 At[4][2], B0[2][2], B1[2][2];
    int nt = cur.nt ? cur.nt : ntK;
    LAS float* rstab = (LAS float*)(lds + STAGE_BYTES + 1024);
    if constexpr (Epi::USES_RS) { if (wid == 0) __builtin_amdgcn_global_load_lds((const unsigned*)(E.RS + (size_t)cur.pm * BM + lane * 4), (LAS unsigned*)(rstab), 16, 0, 0); }
    const char* cA = (const char*)g.A + (size_t)cur.g * g.gsA + (size_t)cur.pm * tstepA + cur.kofs + cur.kofsA;
    const char* cB = (const char*)g.Bt + (size_t)cur.g * g.gsB + (size_t)cur.pn * tstepB + cur.kofs;
    PG8_STAGE(PG8_SB(0, 0), cB, voffB); PG8_STAGE(PG8_SA(0, 0), cA, voffA); PG8_STAGE(PG8_SB(0, 1), cB + hstepB, voffB); PG8_STAGE(PG8_SA(0, 1), cA + hstepA, voffA);
    if (wr == 1) PG8_BAR;
    PG8_WAIT_V(4); PG8_BAR;
    PG8_STAGE(PG8_SB(1, 0), cB + kstep, voffB); PG8_STAGE(PG8_SA(1, 0), cA + kstep, voffA); PG8_STAGE(PG8_SB(1, 1), cB + hstepB + kstep, voffB);
    PG8_WAIT_V(6); PG8_BAR;
    for (;;) {
        const bool has_next = S.next(ui + 1, nxt);
        const char* nA = has_next ? (const char*)g.A + (size_t)nxt.g * g.gsA + (size_t)nxt.pm * tstepA + nxt.kofs + nxt.kofsA : cA;
        const char* nB = has_next ? (const char*)g.Bt + (size_t)nxt.g * g.gsB + (size_t)nxt.pn * tstepB + nxt.kofs : cB;
        for (int t = 0; t < nt; t += 2) {
            const bool last = (t == nt - 2);
            const char* a1 = cA + (size_t)(t + 1) * kstep;
            const char* a2 = last ? nA : cA + (size_t)(t + 2) * kstep; const char* b2 = last ? nB : cB + (size_t)(t + 2) * kstep;
            const char* a3 = a2 + kstep; const char* b3 = b2 + kstep;
            PG8_LDB(B0, 0, 0); PG8_SCHED; PG8_LDA(At, 0, 0); PG8_STAGE(PG8_SA(1, 1), a1 + hstepA, voffA);
            PG8_WAIT_L(8); PG8_BAR; PG8_WAIT_L(0); PG8_MMA(0, 0, At, B0); PG8_BAR; PG8_SCHED;
            PG8_LDB(B1, 0, 1); PG8_STAGE(PG8_SB(0, 0), b2, voffB);
            PG8_BAR; PG8_WAIT_L(0); PG8_MMA(0, 1, At, B1); PG8_BAR;
            PG8_LDA(At, 0, 1); PG8_STAGE(PG8_SA(0, 0), a2, voffA);
            PG8_BAR; PG8_WAIT_L(0); PG8_MMA(1, 0, At, B0); PG8_BAR; PG8_SCHED;
            PG8_STAGE(PG8_SB(0, 1), b2 + hstepB, voffB);
            PG8_WAIT_V(6); PG8_BAR; PG8_MMA(1, 1, At, B1); PG8_BAR;
            PG8_LDB(B0, 1, 0); PG8_SCHED; PG8_LDA(At, 1, 0); PG8_STAGE(PG8_SA(0, 1), a2 + hstepA, voffA);
            PG8_WAIT_L(8); PG8_BAR; PG8_WAIT_L(0); PG8_MMA(0, 0, At, B0); PG8_BAR; PG8_SCHED;
            PG8_LDB(B1, 1, 1); PG8_STAGE(PG8_SB(1, 0), b3, voffB);
            PG8_BAR; PG8_WAIT_L(0); PG8_MMA(0, 1, At, B1); PG8_BAR;
            PG8_LDA(At, 1, 1); PG8_STAGE(PG8_SA(1, 0), a3, voffA);
            PG8_BAR; PG8_WAIT_L(0); PG8_MMA(1, 0, At, B0); PG8_BAR; PG8_SCHED;
            PG8_STAGE(PG8_SB(1, 1), b3 + hstepB, voffB);
            PG8_WAIT_V(6); PG8_BAR; PG8_MMA(1, 1, At, B1); PG8_BAR;
        }
        E(acc, cur, wr, wc, fr, fq, rstab + (ui & 1) * 256);
        if (!has_next) break;
#pragma unroll
        for (int a = 0; a < 2; ++a)
#pragma unroll
            for (int b = 0; b < 2; ++b)
#pragma unroll
                for (int m = 0; m < 4; ++m)
#pragma unroll
                    for (int n = 0; n < 2; ++n) acc[a][b][m][n] = (f32x4){0.f, 0.f, 0.f, 0.f};
        cur = nxt; cA = nA; cB = nB; ++ui; nt = cur.nt ? cur.nt : ntK;
        if constexpr (Epi::USES_RS) { if (wid == 0) __builtin_amdgcn_global_load_lds((const unsigned*)(E.RS + (size_t)cur.pm * BM + lane * 4), (LAS unsigned*)(rstab + (ui & 1) * 256), 16, 0, 0); }
    }
    PG8_WAIT_V(0);
    if (wr == 0) PG8_BAR;
    PG8_BAR;
#undef PG8_SA
#undef PG8_SB
#undef PG8_STAGE
#undef PG8_LDA
#undef PG8_LDB
#undef PG8_MMA
#undef PG8_WAIT_V
#undef PG8_WAIT_L
#undef PG8_BAR
#undef PG8_SCHED
}

__device__ __forceinline__ f32x4 meta_tile(const bf16_t* A, const bf16_t* Brow0, int K, int ldb, int lane) {
    const int fr = lane & 15, fq = lane >> 4;
    const bf16_t* ap = A + (size_t)fr * K + fq * 8; const bf16_t* bp = Brow0 + (size_t)fr * ldb + fq * 8;
    f32x4 acc = {0.f, 0.f, 0.f, 0.f};
#pragma unroll 4
    for (int k = 0; k < K; k += 32) {
        const bf16x8 a = *(const bf16x8*)(ap + k), b = *(const bf16x8*)(bp + k);
        acc = __builtin_amdgcn_mfma_f32_16x16x32_bf16(b, a, acc, 0, 0, 0);
    }
    return acc;
}

__device__ __forceinline__ f32x4 meta_tile_split(const bf16_t* A, const bf16_t* Brow0, int K, int ldb, int lane, int wave, LAS f32x4* red) {
    const int fr = lane & 15, fq = lane >> 4, k0 = wave * (K >> 3), k1 = k0 + (K >> 3);
    const bf16_t* ap = A + (size_t)fr * K + fq * 8; const bf16_t* bp = Brow0 + (size_t)fr * ldb + fq * 8;
    f32x4 acc = {0.f, 0.f, 0.f, 0.f};
#pragma unroll 4
    for (int k = k0; k < k1; k += 32) {
        const bf16x8 a = *(const bf16x8*)(ap + k), b = *(const bf16x8*)(bp + k);
        acc = __builtin_amdgcn_mfma_f32_16x16x32_bf16(b, a, acc, 0, 0, 0);
    }
    red[wave * 64 + lane] = acc;
    asm volatile("s_waitcnt lgkmcnt(0)" ::: "memory"); __syncthreads();
    f32x4 t = {0.f, 0.f, 0.f, 0.f};
    if (wave == 0) {
#pragma unroll
        for (int w = 0; w < 8; ++w) t += red[w * 64 + lane];
    }
    __syncthreads();
    return t;
}

__device__ __forceinline__ void transpose_item(const float* W, int N, bf16_t* WT, int ldt, int dst_row0, LAS float* scr, int k0, int n0, int lane, const float* gk = nullptr) {
#pragma unroll
    for (int i = 0; i < 32; ++i) { const int kk = 2 * i + (lane >> 5); scr[kk * 33 + (lane & 31)] = W[(size_t)(k0 + kk) * N + n0 + (lane & 31)] * (gk ? gk[k0 + kk] : 1.0f); }
    asm volatile("s_waitcnt lgkmcnt(0)" ::: "memory");
    const int c = lane & 7;
#pragma unroll
    for (int j = 0; j < 4; ++j) { const int n = (lane >> 3) + 8 * j; const LAS float* s = scr + (8 * c) * 33 + n;
        u32x4 o; o.x = cvt_pk_bf16(s[0 * 33], s[1 * 33]); o.y = cvt_pk_bf16(s[2 * 33], s[3 * 33]); o.z = cvt_pk_bf16(s[4 * 33], s[5 * 33]); o.w = cvt_pk_bf16(s[6 * 33], s[7 * 33]);
        *(u32x4*)(WT + (size_t)(dst_row0 + n) * ldt + k0 + 8 * c) = o; }
    asm volatile("s_waitcnt lgkmcnt(0)" ::: "memory");
}

__device__ __forceinline__ void rms_row_to_bf16(const float* xrow, const float* gain, bf16_t* orow, int lane) {
    const f32x4* xr = (const f32x4*)xrow + lane; f32x4 v[4]; float s = 0.f;
#pragma unroll
    for (int j = 0; j < 4; ++j) { v[j] = xr[64 * j]; s += (v[j][0] * v[j][0] + v[j][1] * v[j][1]) + (v[j][2] * v[j][2] + v[j][3] * v[j][3]); }
    const float r = rsq(wave_sum(s) * (1.f / DM) + EPS);
    u32x2* o = (u32x2*)orow + lane;
#pragma unroll
    for (int j = 0; j < 4; ++j) { const f32x4 gq = gain ? ((const f32x4*)gain)[lane + 64 * j] : (f32x4){1.f, 1.f, 1.f, 1.f}; u32x2 w; w.x = cvt_pk_bf16(v[j][0] * r * gq[0], v[j][1] * r * gq[1]); w.y = cvt_pk_bf16(v[j][2] * r * gq[2], v[j][3] * r * gq[3]); o[64 * j] = w; }
}

template <bool XN_OUT, bool HIN_BF, bool HOUT_BF>
__device__ __forceinline__ void resid_rows(const void* hin_, const bf16_t* F, const float* SSQ, float coef, const float* gpost, void* hout_, float* RS, int gw, int ngw, int lane) {
    constexpr int R = 8;
    f32x4 gp[4];
#pragma unroll
    for (int j = 0; j < 4; ++j) gp[j] = ((const f32x4*)gpost)[lane + 64 * j];
    const int rpw = (MTOK + ngw - 1) / ngw, mbeg = gw * rpw, mend = (mbeg + rpw < MTOK) ? mbeg + rpw : MTOK;
    for (int m0 = mbeg; m0 < mend; m0 += R) {
        u32x2 v[R][4]; u32x2 fw[R][4]; float sqv[R];
#pragma unroll
        for (int r = 0; r < R; ++r) {
            const int m = (m0 + r < mend) ? m0 + r : m0;
            sqv[r] = SSQ[(size_t)m * 16 + (lane & 15)];
#pragma unroll
            for (int j = 0; j < 4; ++j) {
                static_assert(HIN_BF, "the residual stream is stored as bf16");
                v[r][j] = ((const u32x2*)((const bf16_t*)hin_ + (size_t)m * DM))[lane + 64 * j];
                fw[r][j] = ((const u32x2*)(F + (size_t)m * DM))[lane + 64 * j];
            }
        }
#pragma unroll
        for (int r = 0; r < R; ++r) {
            const int m = m0 + r;
            if (m < mend) {
                float ss = sqv[r]; ss += __shfl_xor(ss, 1); ss += __shfl_xor(ss, 2); ss += __shfl_xor(ss, 4); ss += __shfl_xor(ss, 8);
                const float r1 = rsq(ss * (1.f / DM) + EPS) * coef;
                f32x4 h[4]; float s2 = 0.f;
#pragma unroll
                for (int j = 0; j < 4; ++j) {
                    f32x4 vv;
                    { const unsigned w0 = v[r][j].x, w1 = v[r][j].y; vv[0] = bf_lo(w0); vv[1] = bf_hi(w0); vv[2] = bf_lo(w1); vv[3] = bf_hi(w1); }
                    f32x4 f; f[0] = bf_lo(fw[r][j].x); f[1] = bf_hi(fw[r][j].x); f[2] = bf_lo(fw[r][j].y); f[3] = bf_hi(fw[r][j].y);
                    h[j] = vv + r1 * f * gp[j];
                    s2 += (h[j][0] * h[j][0] + h[j][1] * h[j][1]) + (h[j][2] * h[j][2] + h[j][3] * h[j][3]);
                    if (HOUT_BF) { u32x2 w; w.x = cvt_pk_bf16(h[j][0], h[j][1]); w.y = cvt_pk_bf16(h[j][2], h[j][3]); ((u32x2*)((bf16_t*)hout_ + (size_t)m * DM))[lane + 64 * j] = w; }
                    else ((f32x4*)((float*)hout_ + (size_t)m * DM))[lane + 64 * j] = h[j];
                }
                if (XN_OUT) { const float r2 = rsq(wave_sum(s2) * (1.f / DM) + EPS); if (lane == 0) RS[m] = r2; }
            }
        }
    }
}

#define XB_TMO      128
#define XB_XCNT(j)  (256  + 64 * (j))
#define XB_XSUB(j)  (1280 + 64 * (j))
#define XB_XGEN(j)  (2304 + 64 * (j))
#define XB_TOP      3328
#define XB_TOPGEN   3392
#define XCD_BAR_WORDS 3456
#define XB_RANK(j)  (3520 + 64 * (j))
#define CTL_ZERO_BYTES 16384
#define XB_SPIN_CAP (1u << 22)
__device__ __forceinline__ unsigned xb_ld(unsigned* p)              { return __hip_atomic_load(p, __ATOMIC_RELAXED, __HIP_MEMORY_SCOPE_AGENT); }
__device__ __forceinline__ unsigned xb_add(unsigned* p, unsigned v) { return __hip_atomic_fetch_add(p, v, __ATOMIC_RELAXED, __HIP_MEMORY_SCOPE_AGENT); }
__device__ __forceinline__ unsigned xb_xcc_id() { return (unsigned)__builtin_amdgcn_s_getreg((3 << 11) | 20) & 0xFu; }
#define XB_SPIN(cond, bar) do { unsigned _sp = 0; while (cond) { __builtin_amdgcn_s_sleep(1); \
    if ((++_sp & 255u) == 0u) { if (xb_ld(&(bar)[XB_TMO])) break; if (_sp > XB_SPIN_CAP) { atomicAdd(&(bar)[XB_TMO], 1u); break; } } } } while (0)
struct XcdBarrier { unsigned* bar; unsigned x; volatile LAS unsigned* st; };
__device__ __forceinline__ XcdBarrier xcd_barrier_post(unsigned* bar, volatile LAS unsigned* st) {
    XcdBarrier b; b.bar = bar; b.x = xb_xcc_id(); b.st = st;
    if (threadIdx.x == 0) (void)xb_add(&bar[XB_XCNT(b.x)], 1u);
    return b;
}
__device__ __forceinline__ void xcd_barrier_complete(unsigned* bar, unsigned x, unsigned& nloc, unsigned& nx) {
    const unsigned G = gridDim.x * gridDim.y * gridDim.z;
    unsigned sum, cnt, mine, sp = 0u;
    for (;;) {
        sum = 0u; cnt = 0u; mine = 0u;
#pragma unroll
        for (unsigned j = 0; j < 16; ++j) { const unsigned c = xb_ld(&bar[XB_XCNT(j)]); sum += c; cnt += (c > 0u) ? 1u : 0u; mine = (j == x) ? c : mine; }
        if (sum == G) break;
        __builtin_amdgcn_s_sleep(1);
        if ((++sp & 255u) == 0u) { if (xb_ld(&bar[XB_TMO])) break; if (sp > XB_SPIN_CAP) { atomicAdd(&bar[XB_TMO], 1u); break; } }
    }
    nloc = mine > 0u ? mine : 1u; nx = cnt > 0u ? cnt : 1u;
}
__device__ __forceinline__ void xcd_barrier(const XcdBarrier& b) {
    asm volatile("s_waitcnt vmcnt(0)" ::: "memory");
    __syncthreads();
    if (threadIdx.x == 0) {
        unsigned* bar = b.bar;
        __builtin_amdgcn_s_waitcnt(0);
        unsigned nloc = b.st[0], nx = b.st[1];
        if (nloc == 0u) { xcd_barrier_complete(bar, b.x, nloc, nx); b.st[0] = nloc; b.st[1] = nx; }
        const unsigned old = xb_add(&bar[XB_XSUB(b.x)], 1u);
        const unsigned gen = old / nloc;
        if (old + 1u == (gen + 1u) * nloc) {
            __builtin_amdgcn_fence(__ATOMIC_RELEASE, "agent");
            asm volatile("s_waitcnt vmcnt(0)" ::: "memory");
            const unsigned og = xb_add(&bar[XB_TOP], 1u);
            const unsigned tg = og / nx;
            if (og + 1u == (tg + 1u) * nx) xb_add(&bar[XB_TOPGEN], 1u);
            else XB_SPIN(xb_ld(&bar[XB_TOPGEN]) == tg, bar);
            __builtin_amdgcn_fence(__ATOMIC_ACQUIRE, "agent");
            xb_add(&bar[XB_XGEN(b.x)], 1u);
            asm volatile("s_waitcnt vmcnt(0)" ::: "memory");
        } else {
            XB_SPIN(xb_ld(&bar[XB_XGEN(b.x)]) == gen, bar);
            __builtin_amdgcn_fence(__ATOMIC_ACQUIRE, "agent");
            asm volatile("s_waitcnt vmcnt(0)" ::: "memory");
        }
    }
    __syncthreads();
}


#define GRID_SYNC() xcd_barrier(bar)
__global__ void __launch_bounds__(NTHREADS, 2) hymba_fwd(Params p) {
    extern __shared__ __attribute__((aligned(16))) unsigned char lds_raw[];
    LAS unsigned char* lds = (LAS unsigned char*)lds_raw;
    cg::grid_group grid = cg::this_grid();
    const int tid = threadIdx.x, lane = tid & 63, wave = __builtin_amdgcn_readfirstlane(tid >> 6);
    const int G = gridDim.x, blk = blockIdx.x;
    const int gw = blk * NWAVES + wave, ngw = G * NWAVES;
    const int gt = blk * NTHREADS + tid, ngt = G * NTHREADS;
    unsigned char* ws = p.ws;
    const float* x = p.in[0]; const float* meta = p.in[1];
    SsmP sp; sp.lre = p.in[10]; sp.lim = p.in[11]; sp.logdt = p.in[12]; sp.bre = p.in[13]; sp.bim = p.in[14]; sp.cre = p.in[15]; sp.cim = p.in[16]; sp.dskip = p.in[17]; sp.wglu = p.in[18];
    bf16_t* Wgu1 = (bf16_t*)(ws + WS_WGU1); bf16_t* Wd1 = (bf16_t*)(ws + WS_WD1); bf16_t* Wgu2 = (bf16_t*)(ws + WS_WGU2); bf16_t* Wd2 = (bf16_t*)(ws + WS_WD2);
    bf16_t* Win = (bf16_t*)(ws + WS_WIN); bf16_t* Wout = (bf16_t*)(ws + WS_WOUT); bf16_t* M1 = (bf16_t*)(ws + WS_M1); bf16_t* W2 = (bf16_t*)(ws + WS_W2);
    float* Ktab = (float*)(ws + WS_KTAB);
    bf16_t* xn1m = (bf16_t*)(ws + WS_XN1M); bf16_t* Gm = (bf16_t*)(ws + WS_GM); float* f1m = (float*)(ws + WS_F1M); bf16_t* xn2m = (bf16_t*)(ws + WS_XN2M); float* projm = (float*)(ws + WS_PROJM);
    bf16_t* XN = (bf16_t*)(ws + WS_XN); bf16_t* Fb = (bf16_t*)(ws + WS_F); float* SSQ = (float*)(ws + WS_SSQ); bf16_t* Gbuf = (bf16_t*)(ws + WS_GBUF);
    bf16_t* UG = (bf16_t*)(ws + WS_UG); bf16_t* V = (bf16_t*)(ws + WS_V); bf16_t* OS = (bf16_t*)(ws + WS_OS); float* Sb = (float*)(ws + WS_S); float* SSQS = (float*)(ws + WS_SSQS);
    float* out = p.out; bf16_t* Hb = (bf16_t*)(ws + WS_H); float* EQ = (float*)(ws + WS_EQ); float* EP = (float*)(ws + WS_EP); float* RS = (float*)(ws + WS_RS);
    volatile LAS unsigned* bst = (volatile LAS unsigned*)(lds + STAGE_BYTES);
    if (tid == 0) { bst[0] = 0u; bst[1] = 0u; }
    __syncthreads();
    XcdBarrier bar = xcd_barrier_post((unsigned*)(ws + WS_CTL), bst);
    if (tid == 0) { bst[2] = xb_add((unsigned*)(ws + WS_CTL) + XB_RANK(bar.x), 1u); }
    grid.sync();

    {
        LAS float* scr = (LAS float*)(lds + wave * 16384);
        constexpr int I_GU = (DM / 64) * (FF / 32), I_D = (FF / 64) * (DM / 32), I_IN = (DM / 64) * (512 / 32), I_OUT = (DM / 64) * (DM / 32);
        constexpr int NIT = 4 * I_GU + 2 * I_D + I_IN + I_OUT;
        for (int it = gw; it < NIT; it += ngw) {
            int r = it;
            if (r < 4 * I_GU) {
                const int which = r / I_GU; r -= which * I_GU;
                const float* W = p.in[which == 0 ? 4 : which == 1 ? 5 : which == 2 ? 26 : 27]; bf16_t* WT = which < 2 ? Wgu1 : Wgu2;
                const int nblk = FF / 32, kb = r / nblk, nb = r % nblk, n0 = nb * 32;
                const int drow = 256 * (n0 >> 7) + (n0 & 127) + ((which & 1) ? 128 : 0);
                transpose_item(W, FF, WT, DM, drow, scr, kb * 64, n0, lane, p.in[which < 2 ? 2 : 24]); continue;
            }
            r -= 4 * I_GU;
            if (r < 2 * I_D) {
                const int which = r / I_D; r -= which * I_D;
                const float* W = p.in[which == 0 ? 6 : 28]; bf16_t* WT = which == 0 ? Wd1 : Wd2;
                const int nblk = DM / 32, kb = r / nblk, nb = r % nblk;
                transpose_item(W, DM, WT, FF, nb * 32, scr, kb * 64, nb * 32, lane); continue;
            }
            r -= 2 * I_D;
            if (r < I_IN) { const int nblk = 512 / 32, kb = r / nblk, nb = r % nblk; transpose_item(p.in[9], DM, Win, DM, nb * 32, scr, kb * 64, nb * 32, lane, p.in[7]); continue; }
            r -= I_IN;
            { const int nblk = DM / 32, kb = r / nblk, nb = r % nblk; transpose_item(p.in[23], DM, Wout, DM, nb * 32, scr, kb * 64, nb * 32, lane, kb * 64 < 512 ? p.in[21] : p.in[22] - 512); }
        }
        for (int it = (gw >= ngw / 2) ? gw - ngw / 2 : gw + (ngw - ngw / 2); it < 8 * 128; it += ngw) {
            const int db = it >> 7, k0 = (it & 127) * 8, d = db * 64 + lane, gi = d >> 7, dd = d & 127;
            const float* pw = p.in[19] + (size_t)gi * 128 * 128 + dd; const float* wi = p.in[9] + (size_t)k0 * DM + 512 + gi * 128;
            float a[8];
#pragma unroll
            for (int kk = 0; kk < 8; ++kk) a[kk] = 0.f;
#pragma unroll 32
            for (int c = 0; c < 128; ++c) { const float pv = pw[(size_t)c * 128];
#pragma unroll
                for (int kk = 0; kk < 8; ++kk) a[kk] += wi[(size_t)kk * DM + c] * pv; }
            const float sc = p.in[20][d]; const f32x4 gm0 = *(const f32x4*)(p.in[7] + k0), gm1 = *(const f32x4*)(p.in[7] + k0 + 4);
            u32x4 o; o.x = cvt_pk_bf16(a[0] * sc * gm0[0], a[1] * sc * gm0[1]); o.y = cvt_pk_bf16(a[2] * sc * gm0[2], a[3] * sc * gm0[3]); o.z = cvt_pk_bf16(a[4] * sc * gm1[0], a[5] * sc * gm1[1]); o.w = cvt_pk_bf16(a[6] * sc * gm1[2], a[7] * sc * gm1[3]);
            *(u32x4*)(Win + (size_t)(512 + d) * DM + k0) = o;
        }
        for (int it = gw; it < 32 * 64; it += ngw) {
            const int g = it >> 6, tau = it & 63;
            { float er, ei, qr, qi; ssm_apow(sp, g, lane, (float)tau, er, ei); ssm_q(sp, g, lane, qr, qi);
              scr[lane] = er * qr - ei * qi; scr[64 + lane] = er * qi + ei * qr; }
            asm volatile("s_waitcnt lgkmcnt(0)" ::: "memory");
            const int ho = lane >> 2, hq = lane & 3;
            float a0 = 0.f, a1 = 0.f, a2 = 0.f, a3 = 0.f;
#pragma unroll 16
            for (int n = 0; n < 64; ++n) {
                const float fr_ = scr[n], fi_ = scr[64 + n];
                const float cr = sp.cre[(size_t)(g * 16 + ho) * 64 + n], ci = sp.cim[(size_t)(g * 16 + ho) * 64 + n];
                const float wr_ = cr * fr_ - ci * fi_, wi_ = cr * fi_ + ci * fr_;
                const f32x4 br = *(const f32x4*)(sp.bre + (size_t)(g * 64 + n) * 16 + 4 * hq), bi = *(const f32x4*)(sp.bim + (size_t)(g * 64 + n) * 16 + 4 * hq);
                a0 += wr_ * br[0] - wi_ * bi[0]; a1 += wr_ * br[1] - wi_ * bi[1]; a2 += wr_ * br[2] - wi_ * bi[2]; a3 += wr_ * br[3] - wi_ * bi[3];
            }
            if (tau == 0) { const float dv = sp.dskip[g * 16 + ho]; const int j = ho - 4 * hq; if (j == 0) a0 += dv; if (j == 1) a1 += dv; if (j == 2) a2 += dv; if (j == 3) a3 += dv; }
            *(f32x4*)(Ktab + ((size_t)(g * 64 + tau) * 16 + ho) * 16 + 4 * hq) = (f32x4){a0, a1, a2, a3};
            asm volatile("s_waitcnt lgkmcnt(0)" ::: "memory");
        }
        for (int it = gt; it < 32 * 65 * 64; it += ngt) {
            const int n = it & 63, pg = it >> 6, pp = pg % 65, g = pg / 65;
            float er, ei, qr, qi; ssm_apow(sp, g, n, (float)pp, er, ei); ssm_q(sp, g, n, qr, qi);
            *(float2*)(EP + ((size_t)(g * 65 + pp) * 64 + n) * 2) = make_float2(er, ei);
            if (pp < 64) *(float2*)(EQ + ((size_t)(g * 64 + pp) * 64 + n) * 2) = make_float2(er * qr - ei * qi, er * qi + ei * qr);
        }
        {
            const int rpw = (MTOK + ngw - 1) / ngw, mbeg = gw * rpw, mend = (mbeg + rpw < MTOK) ? mbeg + rpw : MTOK;
            for (int m0 = mbeg; m0 < mend; m0 += 8) {
                f32x4 v[8][4];
#pragma unroll
                for (int r = 0; r < 8; ++r) { const int m = (m0 + r < mend) ? m0 + r : m0;
#pragma unroll
                    for (int j = 0; j < 4; ++j) v[r][j] = ((const f32x4*)(x + (size_t)m * DM))[lane + 64 * j]; }
#pragma unroll
                for (int r = 0; r < 8; ++r) { const int m = m0 + r; if (m < mend) {
                    float ss = 0.f;
                    u32x2* o = (u32x2*)(XN + (size_t)m * DM) + lane;
#pragma unroll
                    for (int j = 0; j < 4; ++j) { ss += (v[r][j][0] * v[r][j][0] + v[r][j][1] * v[r][j][1]) + (v[r][j][2] * v[r][j][2] + v[r][j][3] * v[r][j][3]);
                        u32x2 w; w.x = cvt_pk_bf16(v[r][j][0], v[r][j][1]); w.y = cvt_pk_bf16(v[r][j][2], v[r][j][3]); o[64 * j] = w; }
                    const float rr = rsq(wave_sum(ss) * (1.f / DM) + EPS); if (lane == 0) RS[m] = rr; } }
            }
        }
        if (gw < 16) rms_row_to_bf16(meta + (size_t)gw * DM, nullptr, xn1m + (size_t)gw * DM, lane);
    }
    GRID_SYNC();

    int vid = blk;
    { bool even = (G % 8) == 0;
      for (unsigned j = 0; j < 16; ++j) { const unsigned cnt = xb_ld((unsigned*)(ws + WS_CTL) + XB_XCNT(j)); if (cnt != (j < 8 ? (unsigned)(G / 8) : 0u)) even = false; }
      const unsigned rk = bst[2];
      if (even && rk < (unsigned)(G / 8) && bar.x < 8u) vid = (int)(rk * 8u + bar.x); }
    vid = __builtin_amdgcn_readfirstlane(vid);
    {
        for (int it0 = gt; it0 < 32 * 256 * 128; it0 += 4 * ngt) {
            u32x4 ov[4];
#pragma unroll
            for (int u = 0; u < 4; ++u) {
                const int it = it0 + u * ngt; u32x4 o = {0u, 0u, 0u, 0u};
                const int kc = it & 127, row = (it >> 7) & 255, g = (it >> 15) & 31;
                if (it < 32 * 256 * 128 && row < 128) {
                    const int n = row & 63, part = row >> 6, s = kc >> 1, hi0 = (kc & 1) * 8;
                    const float2 f = *(const float2*)(EQ + ((size_t)(g * 64 + (63 - s)) * 64 + n) * 2);
                    const float* br = sp.bre + (size_t)(g * 64 + n) * 16 + hi0; const float* bi = sp.bim + (size_t)(g * 64 + n) * 16 + hi0;
                    const f32x4 b0 = *(const f32x4*)br, b1 = *(const f32x4*)(br + 4), c0 = *(const f32x4*)bi, c1 = *(const f32x4*)(bi + 4);
                    f32x4 v0, v1;
                    if (part == 0) { v0 = f.x * b0 - f.y * c0; v1 = f.x * b1 - f.y * c1; } else { v0 = f.x * c0 + f.y * b0; v1 = f.x * c1 + f.y * b1; }
                    o.x = cvt_pk_bf16(v0[0], v0[1]); o.y = cvt_pk_bf16(v0[2], v0[3]); o.z = cvt_pk_bf16(v1[0], v1[1]); o.w = cvt_pk_bf16(v1[2], v1[3]);
                }
                ov[u] = o;
            }
#pragma unroll
            for (int u = 0; u < 4; ++u) { const int it = it0 + u * ngt; if (it < 32 * 256 * 128) { const int kc = it & 127, row = (it >> 7) & 255, g = it >> 15; *(u32x4*)(W2 + ((size_t)(g * 256 + row) * 1024 + kc * 8)) = ov[u]; } }
        }
        for (int it0 = gt; it0 < 32 * 1024 * 144; it0 += 4 * ngt) {
            u32x4 ov[4];
#pragma unroll
            for (int u = 0; u < 4; ++u) {
                const int it = (it0 + u * ngt < 32 * 1024 * 144) ? it0 + u * ngt : it0; u32x4 o = {0u, 0u, 0u, 0u};
                const int kc = it % 144, rg = it / 144, row = rg & 1023, g = rg >> 10, t = row >> 4, ho = row & 15;
                if (kc * 8 >= 128 + 256 * ((row >> 8) + 1)) { ov[u] = o; continue; }
                if (kc >= 16) {
                    const int s = (kc - 16) >> 1, hi0 = (kc & 1) * 8;
                    if (s <= t) { const float* kp = Ktab + ((size_t)(g * 64 + (t - s)) * 16 + ho) * 16 + hi0; const f32x4 k0 = *(const f32x4*)kp, k1 = *(const f32x4*)(kp + 4);
                        o.x = cvt_pk_bf16(k0[0], k0[1]); o.y = cvt_pk_bf16(k0[2], k0[3]); o.z = cvt_pk_bf16(k1[0], k1[1]); o.w = cvt_pk_bf16(k1[2], k1[3]); }
                } else {
                    const int kk = kc * 8, part = kk >> 6, n0 = kk & 63;
                    const float* ep = EP + ((size_t)(g * 65 + t + 1) * 64 + n0) * 2; const float* cr = sp.cre + (size_t)(g * 16 + ho) * 64 + n0; const float* ci = sp.cim + (size_t)(g * 16 + ho) * 64 + n0;
                    float v[8];
#pragma unroll
                    for (int j = 0; j < 8; ++j) { const float er = ep[2 * j], ei = ep[2 * j + 1]; v[j] = part == 0 ? (cr[j] * er - ci[j] * ei) : -(cr[j] * ei + ci[j] * er); }
                    o.x = cvt_pk_bf16(v[0], v[1]); o.y = cvt_pk_bf16(v[2], v[3]); o.z = cvt_pk_bf16(v[4], v[5]); o.w = cvt_pk_bf16(v[6], v[7]);
                }
                ov[u] = o;
            }
#pragma unroll
            for (int u = 0; u < 4; ++u) { const int it = it0 + u * ngt; if (it < 32 * 1024 * 144) { const int kc = it % 144, rg = it / 144, row = rg & 1023, g = rg >> 10; if (kc * 8 < 128 + 256 * ((row >> 8) + 1)) *(u32x4*)(M1 + ((size_t)(g * 1024 + row) * KY + kc * 8)) = ov[u]; } }
        }
        for (int tile = blk; tile < FF / 16; tile += G) {
            const int n0 = tile * 16, grow = 256 * (n0 >> 7) + (n0 & 127), fr = lane & 15, fq = lane >> 4;
            const f32x4 ag = meta_tile_split(xn1m, Wgu1 + (size_t)grow * DM, DM, DM, lane, wave, (LAS f32x4*)lds);
            const f32x4 au = meta_tile_split(xn1m, Wgu1 + (size_t)(grow + 128) * DM, DM, DM, lane, wave, (LAS f32x4*)lds);
            if (wave == 0) { u32x2 w; w.x = cvt_pk_bf16(silu_f(ag[0]) * au[0], silu_f(ag[1]) * au[1]); w.y = cvt_pk_bf16(silu_f(ag[2]) * au[2], silu_f(ag[3]) * au[3]);
                *(u32x2*)(Gm + (size_t)fr * FF + n0 + 4 * fq) = w; }
        }
        Gemm gm{XN, Wgu1, DM, DM, DM, 0, 0}; StaticOrder S; S.init(MTOK, 2 * FF, G, vid); EpiSwiGLU E{Gbuf, RS};
        gemm_phase(lds, gm, S, E);
    }
    GRID_SYNC();

    {
        for (int tile = blk; tile < DM / 16; tile += G) { const int n0 = tile * 16, fr = lane & 15, fq = lane >> 4; const f32x4 a = meta_tile_split(Gm, Wd1 + (size_t)n0 * FF, FF, FF, lane, wave, (LAS f32x4*)lds); if (wave == 0) *(f32x4*)(f1m + (size_t)fr * DM + n0 + 4 * fq) = a; }
        Gemm gm{Gbuf, Wd1, FF, FF, FF, 0, 0}; StaticOrder S; S.init(MTOK, DM, G, vid); EpiRowSsq E{Fb, SSQ};
        gemm_phase(lds, gm, S, E);
    }
    GRID_SYNC();

    {
        resid_rows<true, true, true>(XN, Fb, SSQ, 0.5f, p.in[3], Hb, RS, gw, ngw, lane);
        if (gw < 16) {
            const f32x4* hr = (const f32x4*)(meta + (size_t)gw * DM) + lane; const f32x4* fr4 = (const f32x4*)(f1m + (size_t)gw * DM) + lane;
            f32x4 v[4], f[4]; float s = 0.f;
#pragma unroll
            for (int j = 0; j < 4; ++j) { v[j] = hr[64 * j]; f[j] = fr4[64 * j]; s += (f[j][0] * f[j][0] + f[j][1] * f[j][1]) + (f[j][2] * f[j][2] + f[j][3] * f[j][3]); }
            const float r1 = 0.5f * rsq(wave_sum(s) * (1.f / DM) + EPS); float s2 = 0.f;
#pragma unroll
            for (int j = 0; j < 4; ++j) { const f32x4 gp = ((const f32x4*)p.in[3])[lane + 64 * j]; v[j] = v[j] + r1 * f[j] * gp; s2 += (v[j][0] * v[j][0] + v[j][1] * v[j][1]) + (v[j][2] * v[j][2] + v[j][3] * v[j][3]); }
            const float r2 = rsq(wave_sum(s2) * (1.f / DM) + EPS);
            u32x2* o = (u32x2*)(xn2m + (size_t)gw * DM) + lane;
#pragma unroll
            for (int j = 0; j < 4; ++j) { u32x2 w; w.x = cvt_pk_bf16(v[j][0] * r2, v[j][1] * r2); w.y = cvt_pk_bf16(v[j][2] * r2, v[j][3] * r2); o[64 * j] = w; }
        }
    }
    GRID_SYNC();

    {
        for (int tile = blk; tile < DM / 16; tile += G) { const int n0 = tile * 16, fr = lane & 15, fq = lane >> 4; const f32x4 a = meta_tile_split(xn2m, Win + (size_t)n0 * DM, DM, DM, lane, wave, (LAS f32x4*)lds); if (wave == 0) { *(f32x4*)(projm + (size_t)fr * DM + n0 + 4 * fq) = a;
            if (n0 >= 512) { u32x2 w; w.x = cvt_pk_bf16(a[0], a[1]); w.y = cvt_pk_bf16(a[2], a[3]);
                for (int b = 0; b < 8; ++b) *(u32x2*)(V + ((size_t)b * 8208 + fr) * 512 + (n0 - 512) + 4 * fq) = w; } } }
        Gemm gm{Hb, Win, DM, DM, DM, 0, 0}; StaticOrder S; S.init(MTOK, DM, G, vid); EpiProj E{UG, V, RS};
        gemm_phase(lds, gm, S, E);
    }
    GRID_SYNC();

    {
        Gemm gm{UG, W2, KY, 1024, 512, (size_t)NCHUNK * KY * 2, (size_t)256 * 1024 * 2}; OrderS S{G, vid}; EpiS E{Sb};
        gemm_phase(lds, gm, S, E);
    }
    GRID_SYNC();

    if (wave == 0) {
        for (int it = blk; it < 256; it += G) {
            const int b = it >> 5, g = it & 31, n = lane;
            float ar, ai, qr, qi, a64r, a64i; ssm_apow(sp, g, n, 1.0f, ar, ai); ssm_q(sp, g, n, qr, qi); ssm_apow(sp, g, n, 64.0f, a64r, a64i);
            const float* br = sp.bre + (size_t)(g * 64 + n) * 16; const float* bi = sp.bim + (size_t)(g * 64 + n) * 16;
            float xr = 0.f, xi = 0.f;
            for (int t = 0; t < 16; ++t) {
                const float* up = projm + (size_t)t * DM + g * 16; float sr = 0.f, si = 0.f;
#pragma unroll
                for (int h = 0; h < 16; ++h) { const float uv = up[h]; sr += br[h] * uv; si += bi[h] * uv; }
                const float bur = qr * sr - qi * si, bui = qr * si + qi * sr;
                const float nxr = ar * xr - ai * xi + bur, nxi = ar * xi + ai * xr + bui; xr = nxr; xi = nxi;
            }
            const float* sp0 = Sb + ((size_t)g * NCHUNK + b * 128) * 128 + n; bf16_t* xo = UG + ((size_t)g * NCHUNK + b * 128) * KY + n;
            for (int c0 = 0; c0 < 128; c0 += 16) {
                float svr[16], svi[16];
#pragma unroll
                for (int u = 0; u < 16; ++u) { const float* q0 = sp0 + (size_t)(c0 + u) * 128; const float* q1 = q0 + (size_t)32 * NCHUNK * 128; svr[u] = q0[0] + q1[0]; svi[u] = q0[64] + q1[64]; }
#pragma unroll
                for (int u = 0; u < 16; ++u) {
                    const unsigned pk = cvt_pk_bf16(xr, xi);
                    xo[(size_t)(c0 + u) * KY] = (bf16_t)(pk & 0xffff); xo[(size_t)(c0 + u) * KY + 64] = (bf16_t)(pk >> 16);
                    const float nxr = a64r * xr - a64i * xi + svr[u], nxi = a64r * xi + a64i * xr + svi[u]; xr = nxr; xi = nxi;
                }
            }
        }
    }
    GRID_SYNC();

    {
        Gemm gm{UG, M1, KY, KY, KY, (size_t)NCHUNK * KY * 2, (size_t)1024 * KY * 2}; OrderY S{G, vid}; EpiY E{sp.wglu, XN, SSQS};
        gemm_phase(lds, gm, S, E);

    }
    GRID_SYNC();

    {
        const int wl = 2 << (lane >> 4); const float winv = 1.0f / (float)wl;
        const int rpw = (MTOK + ngw - 1) / ngw, rbeg = gw * rpw, rend = (rbeg + rpw < MTOK) ? rbeg + rpw : MTOK;
        for (int r0 = rbeg; r0 < rend; r0 += 4) {
            const bool fast = (r0 + 3 < rend);
            if (fast) {
                float sq[4]; u32x4 qv[19];
#pragma unroll
                for (int t = 0; t < 4; ++t) { const int r = r0 + t;
                    sq[t] = SSQS[((size_t)((lane & 31) * 4 + ((r & 63) >> 4)) * NCHUNK + (r >> 6)) * 16 + (r & 15)]; }
                const int vr3 = r0 + 3 + 16 * (((r0 + 3) >> 13) + 1);
#pragma unroll
                for (int k = 0; k < 19; ++k) qv[k] = (k < wl + 3) ? *(const u32x4*)(V + (size_t)(vr3 - k) * 512 + 8 * lane) : (u32x4){0u, 0u, 0u, 0u};
#pragma unroll
                for (int t = 0; t < 4; ++t) { const int r = r0 + t;
                    const float irs = sqrtf(wave_sum(sq[t]) * 0.5f * (1.f / 512) + EPS);
                    if (lane == 0) RS[r] = 1.0f / irs;
                    float a[8];
#pragma unroll
                    for (int q = 0; q < 8; ++q) a[q] = 0.f;
#pragma unroll
                    for (int d = 0; d < 16; ++d) { const u32x4 q = qv[d + 3 - t]; const float msk = (d < wl) ? 1.0f : 0.0f;
                        a[0] += msk * bf_lo(q.x); a[1] += msk * bf_hi(q.x); a[2] += msk * bf_lo(q.y); a[3] += msk * bf_hi(q.y); a[4] += msk * bf_lo(q.z); a[5] += msk * bf_hi(q.z); a[6] += msk * bf_lo(q.w); a[7] += msk * bf_hi(q.w); }
                    const u32x4 c = qv[3 - t];
                    const float cur[8] = {bf_lo(c.x), bf_hi(c.x), bf_lo(c.y), bf_hi(c.y), bf_lo(c.z), bf_hi(c.z), bf_lo(c.w), bf_hi(c.w)};
                    float ss = 0.f;
#pragma unroll
                    for (int q = 0; q < 8; ++q) { a[q] = a[q] * winv - cur[q]; ss += a[q] * a[q]; }
                    const float rp = rsq(wave_sum(ss) * (1.f / 512) + EPS);
                    const float sc = rp * irs;
                    u32x4 w2; w2.x = cvt_pk_bf16(a[0] * sc, a[1] * sc); w2.y = cvt_pk_bf16(a[2] * sc, a[3] * sc); w2.z = cvt_pk_bf16(a[4] * sc, a[5] * sc); w2.w = cvt_pk_bf16(a[6] * sc, a[7] * sc);
                    *(u32x4*)(XN + (size_t)r * DM + 512 + 8 * lane) = w2; }
            } else {
                for (int tt = 0; tt < 4; ++tt) { const int r = r0 + tt; if (r >= rend) break;
        const int tl = r & 8191;
        const float irs = sqrtf(wave_sum(SSQS[((size_t)((lane & 31) * 4 + ((r & 63) >> 4)) * NCHUNK + (r >> 6)) * 16 + (r & 15)]) * 0.5f * (1.f / 512) + EPS);
        if (lane == 0) RS[r] = 1.0f / irs;
        {
            const int wlen = 2 << (lane >> 4);
            float a[8], cur[8];
#pragma unroll
            for (int j = 0; j < 8; ++j) { a[j] = 0.f; cur[j] = 0.f; }
            for (int d = 0; d < 16; ++d) {
                if (d < wlen) {
                    float v[8];
                    { const u32x4 q = *(const u32x4*)(V + (size_t)(r + 16 * ((r >> 13) + 1) - d) * 512 + 8 * lane);
                        v[0] = bf_lo(q.x); v[1] = bf_hi(q.x); v[2] = bf_lo(q.y); v[3] = bf_hi(q.y); v[4] = bf_lo(q.z); v[5] = bf_hi(q.z); v[6] = bf_lo(q.w); v[7] = bf_hi(q.w); }
#pragma unroll
                    for (int j = 0; j < 8; ++j) { a[j] += v[j]; if (d == 0) cur[j] = v[j]; }
                }
            }
            const float inv = 1.0f / (float)wlen; float s = 0.f;
#pragma unroll
            for (int j = 0; j < 8; ++j) { a[j] = a[j] * inv - cur[j]; s += a[j] * a[j]; }
            const float rp = rsq(wave_sum(s) * (1.f / 512) + EPS);
            const float sc = rp * irs;
            u32x4 w; w.x = cvt_pk_bf16(a[0] * sc, a[1] * sc); w.y = cvt_pk_bf16(a[2] * sc, a[3] * sc); w.z = cvt_pk_bf16(a[4] * sc, a[5] * sc); w.w = cvt_pk_bf16(a[6] * sc, a[7] * sc);
            *(u32x4*)(XN + (size_t)r * DM + 512 + 8 * lane) = w;
        }
                    }
            }
        }
    }
    GRID_SYNC();

    {
        Gemm gm{XN, Wout, DM, DM, DM, 0, 0}; StaticOrder S; S.init(MTOK, DM, G, vid); EpiRowSsqScaled E{Fb, SSQ, RS};
        gemm_phase(lds, gm, S, E);
    }
    GRID_SYNC();

    resid_rows<true, true, true>(Hb, Fb, SSQ, 1.0f, p.in[8], Hb, RS, gw, ngw, lane);
    GRID_SYNC();

    {
        Gemm gm{Hb, Wgu2, DM, DM, DM, 0, 0}; StaticOrder S; S.init(MTOK, 2 * FF, G, vid); EpiSwiGLU E{Gbuf, RS};
        gemm_phase(lds, gm, S, E);
    }
    GRID_SYNC();
    {
        Gemm gm{Gbuf, Wd2, FF, FF, FF, 0, 0}; StaticOrder S; S.init(MTOK, DM, G, vid); EpiRowSsq E{Fb, SSQ};
        gemm_phase(lds, gm, S, E);
    }
    GRID_SYNC();

    resid_rows<false, true, false>(Hb, Fb, SSQ, 0.5f, p.in[25], out, nullptr, gw, ngw, lane);
}

extern "C" void kernel_launch(void* const* d_in, const int* in_sizes, int n_in, void* d_out, int out_size, void* d_ws, size_t ws_size, hipStream_t stream) {
    constexpr size_t kDynLds = STAGE_BYTES + 4096;
    static int grid_blocks = 0;
    if (!grid_blocks) {
        int dev = 0, cus = 0, per_cu = 0;
        hipGetDevice(&dev);
        hipDeviceGetAttribute(&cus, hipDeviceAttributeMultiprocessorCount, dev);
        hipFuncSetAttribute((const void*)hymba_fwd, hipFuncAttributeMaxDynamicSharedMemorySize, (int)kDynLds);
        hipOccupancyMaxActiveBlocksPerMultiprocessor(&per_cu, (const void*)hymba_fwd, NTHREADS, kDynLds);
        if (per_cu < 1) { fprintf(stderr, "occupancy query returned %d\n", per_cu); per_cu = 1; }
        grid_blocks = cus;
        if (ws_size < WS_END) fprintf(stderr, "workspace too small: %zu < %zu\n", ws_size, (size_t)WS_END);
    }
    (void)hipMemsetAsync((char*)d_ws + WS_CTL, 0, CTL_ZERO_BYTES, stream);
    Params p{};
    for (int i = 0; i < 29; ++i) p.in[i] = (const float*)d_in[i];
    p.out = (float*)d_out; p.ws = (unsigned char*)d_ws;
    void* args[] = {&p};
    hipError_t e = hipLaunchCooperativeKernel((const void*)hymba_fwd, dim3(grid_blocks), dim3(NTHREADS), args, kDynLds, stream);
    if (e != hipSuccess) fprintf(stderr, "cooperative launch failed: %s (grid %d)\n", hipGetErrorString(e), grid_blocks);
}
```

```cpp
#include <hip/hip_runtime.h>
#include <hip/hip_cooperative_groups.h>
#include <cstdio>
namespace cg = cooperative_groups;

#define LAS __attribute__((address_space(3)))
typedef unsigned short bf16_t;
typedef short bf16x8 __attribute__((ext_vector_type(8)));
typedef short bf16x4 __attribute__((ext_vector_type(4)));
typedef float f32x4 __attribute__((ext_vector_type(4)));
typedef unsigned u32x4 __attribute__((ext_vector_type(4)));
typedef unsigned u32x2 __attribute__((ext_vector_type(2)));

constexpr int MTOK = 65536;
constexpr int DM = 1024, FF = 2816, NCHUNK = 1024, KY = 1152;
constexpr float EPS = 1e-6f;
constexpr int NTHREADS = 512, NWAVES = 8;

constexpr size_t al256(size_t x) { return (x + 255) & ~(size_t)255; }
constexpr size_t WS_CTL   = 0;
constexpr size_t WS_WGU1  = 65536;
constexpr size_t SZ_WGU   = (size_t)2 * FF * DM * 2;
constexpr size_t WS_WD1   = WS_WGU1 + SZ_WGU;
constexpr size_t SZ_WD    = (size_t)DM * FF * 2;
constexpr size_t WS_WGU2  = WS_WD1 + SZ_WD;
constexpr size_t WS_WD2   = WS_WGU2 + SZ_WGU;
constexpr size_t WS_WIN   = WS_WD2 + SZ_WD;
constexpr size_t WS_WOUT  = WS_WIN + (size_t)DM * DM * 2;
constexpr size_t WS_M1    = WS_WOUT + (size_t)DM * DM * 2;
constexpr size_t SZ_M1    = (size_t)32 * 1024 * KY * 2;
constexpr size_t WS_W2    = WS_M1 + SZ_M1;
constexpr size_t SZ_W2    = (size_t)32 * 256 * 1024 * 2;
constexpr size_t WS_KTAB  = WS_W2 + SZ_W2;
constexpr size_t SZ_KTAB  = (size_t)32 * 64 * 256 * 4;
constexpr size_t WS_XN1M  = WS_KTAB + SZ_KTAB;
constexpr size_t WS_GM    = WS_XN1M + 16 * DM * 2;
constexpr size_t WS_F1M   = al256(WS_GM + 16 * FF * 2);
constexpr size_t WS_XN2M  = WS_F1M + 16 * DM * 4;
constexpr size_t WS_PROJM = WS_XN2M + 16 * DM * 2;
constexpr size_t WS_XN    = WS_PROJM + 16 * DM * 4;
constexpr size_t WS_F     = WS_XN + (size_t)MTOK * DM * 2;
constexpr size_t WS_SSQ   = WS_F + (size_t)MTOK * DM * 2;
constexpr size_t WS_GBUF  = WS_SSQ + (size_t)MTOK * 16 * 4;
constexpr size_t SZ_GBUF  = (size_t)MTOK * FF * 2;
constexpr size_t WS_UG    = WS_GBUF;
constexpr size_t SZ_UG    = (size_t)32 * 1024 * KY * 2;
constexpr size_t WS_V     = WS_UG + SZ_UG;
constexpr int VROWS = 8 * (8192 + 16);
constexpr size_t WS_S     = WS_V + (size_t)VROWS * 512 * 2;
constexpr size_t WS_END0  = WS_GBUF + SZ_GBUF;
constexpr size_t WS_OS    = WS_END0;
constexpr size_t WS_SSQS  = WS_OS + (size_t)MTOK * 512 * 2;
constexpr size_t WS_H     = WS_SSQS + (size_t)MTOK * 32 * 4;
constexpr size_t WS_EQ    = WS_H + (size_t)MTOK * DM * 2;
constexpr size_t WS_EP    = WS_EQ + (size_t)32 * 64 * 64 * 8;
constexpr size_t WS_RS    = WS_EP + (size_t)32 * 65 * 64 * 8;
constexpr size_t WS_END   = WS_RS + (size_t)MTOK * 4;
static_assert(WS_S + (size_t)2 * 32 * 1024 * 128 * 4 <= WS_END0, "alias region overflow");

struct Params { const float* in[29]; float* out; unsigned char* ws; };

typedef float f32x2c __attribute__((ext_vector_type(2)));
typedef __bf16 bf16x2c __attribute__((ext_vector_type(2)));
__device__ __forceinline__ unsigned cvt_pk_bf16(float lo, float hi) { const f32x2c v = {lo, hi}; const bf16x2c r = __builtin_convertvector(v, bf16x2c); return __builtin_bit_cast(unsigned, r); }
__device__ __forceinline__ float bf_lo(unsigned w) { return __uint_as_float(w << 16); }
__device__ __forceinline__ float bf_hi(unsigned w) { return __uint_as_float(w & 0xffff0000u); }
__device__ __forceinline__ float wave_sum(float v) {
#pragma unroll
    for (int o = 1; o < 64; o <<= 1) v += __shfl_xor(v, o);
    return v;
}
__device__ __forceinline__ float fast_sigmoid(float z) { return __builtin_amdgcn_rcpf(1.0f + __builtin_amdgcn_exp2f(-1.4426950408889634f * z)); }
__device__ __forceinline__ float silu_f(float x) { return x * fast_sigmoid(x); }
__device__ __forceinline__ float gelu_tanh_f(float x) { const float z = 0.7978845608028654f * (x + 0.044715f * x * x * x); return x * fast_sigmoid(2.0f * z); }
__device__ __forceinline__ float rsq(float x) { return 1.0f / sqrtf(x); }

struct SsmP { const float *lre, *lim, *logdt, *bre, *bim, *cre, *cim, *dskip, *wglu; };
__device__ __forceinline__ void ssm_apow(const SsmP& P, int g, int n, float p, float& er, float& ei) {
    const float dt = expf(P.logdt[g]); const float lr = P.lre[g * 64 + n], li = P.lim[g * 64 + n];
    const float mag = expf(lr * dt * p);
    double turns = (double)li * (double)dt * (double)p * 0.15915494309189535;
    turns -= rint(turns);
    const float tf = (float)turns;
    er = mag * __builtin_amdgcn_cosf(tf); ei = mag * __builtin_amdgcn_sinf(tf);
}
__device__ __forceinline__ void ssm_q(const SsmP& P, int g, int n, float& qr, float& qi) {
    const float dt = expf(P.logdt[g]); const float lr = P.lre[g * 64 + n], li = P.lim[g * 64 + n];
    const float em1 = expm1f(lr * dt), decay = 1.0f + em1;
    double turns = (double)li * (double)dt * 0.15915494309189535;
    double t1 = turns - rint(turns); double t2 = turns * 0.5; t2 -= rint(t2);
    const float c = __builtin_amdgcn_cosf((float)t1), s = __builtin_amdgcn_sinf((float)t1), sh = __builtin_amdgcn_sinf((float)t2);
    const float ai = decay * s;
    const float nr = em1 * c - 2.0f * sh * sh;
    const float den = lr * lr + li * li;
    qr = (nr * lr + ai * li) / den; qi = (ai * lr - nr * li) / den;
}

constexpr int BM = 256, BK = 64, HALF = 128, HTB = HALF * BK * 2, STAGE_BYTES = 8 * HTB, NXCD = 8, WGM = 8;
__device__ __forceinline__ int lds_byte(int r, int c) { const int st = (r >> 4) * 2 + (c >> 5), rr = r & 15, cc = c & 31, ob = rr * 64 + cc * 2; return st * 1024 + (ob ^ (((ob >> 9) & 1) << 5)); }
__device__ __forceinline__ void stage_rc(int b, int& R, int& C) { const int st = b / 1024, sb = b % 1024, swz = sb ^ (((sb >> 9) & 1) << 5); R = (st >> 1) * 16 + swz / 64; C = (st & 1) * 32 + (swz % 64) / 2; }
__device__ __forceinline__ int perm32(int rho) { const int n = rho >> 4, i = rho & 15; return 8 * (i >> 2) + 4 * n + (i & 3); }

struct Unit { int pm, pn, g, kofs, kofsA, nt; };
struct Gemm { const bf16_t* A; const bf16_t* Bt; int lda, ldb, K; size_t gsA, gsB; };

struct StaticOrder {
    int nM, nN, nwg, G, c;
    __device__ void init(int M, int N, int G_, int c_) { nM = M / BM; nN = N / BM; nwg = nM * nN; G = G_; c = c_; }
    __device__ bool next(int i, Unit& u) const {
        const long L = (long)i * G + c; if (L >= nwg) return false;
        int wgid = (int)L; { const int q = nwg / NXCD, r = nwg % NXCD, xcd = wgid % NXCD, off = wgid / NXCD; wgid = (xcd < r ? xcd * (q + 1) : r * (q + 1) + (xcd - r) * q) + off; }
        const int nig = WGM * nN, gid = wgid / nig, fm = gid * WGM, gsz = (nM - fm) < WGM ? (nM - fm) : WGM;
        u.pm = fm + ((wgid % nig) % gsz); u.pn = (wgid % nig) / gsz; u.g = 0; u.kofs = 0; u.kofsA = 0; u.nt = 0; return true;
    }
};
struct OrderS {
    int G, c;
    __device__ bool next(int i, Unit& u) const { const int L = i * G + c; if (L >= 256) return false; u.g = L >> 3; u.pm = (L >> 1) & 3; u.pn = 0; u.kofs = (L & 1) * 1024; u.kofsA = 256; u.nt = 0; return true; }
};
struct OrderY {
    int G, c;
    __device__ bool next(int i, Unit& u) const { const int L = i * G + c; if (L >= 512) return false; const int l = L & 255;
        u.g = l >> 3; u.pm = (l >> 1) & 3; u.pn = (L < 256) ? (l & 1) : 3 - (l & 1); u.kofs = 0; u.kofsA = 0; u.nt = 2 + 4 * (u.pn + 1); return true; }
};

typedef f32x4 Acc[2][2][4][2];

struct EpiSwiGLU {
    static constexpr bool PERM = true;
    bf16_t* G; const float* RS;
    static constexpr bool USES_RS = true;
    __device__ __forceinline__ void operator()(const Acc& acc, const Unit& u, int wr, int wc, int fr, int fq, const LAS float* rsl) const {
        const int row0 = u.pm * BM + wr * 64 + fr, col0 = u.pn * 128 + wc * 32 + 8 * fq;
        float rsv[2][4];
#pragma unroll
        for (int ai = 0; ai < 2; ++ai)
#pragma unroll
            for (int m = 0; m < 4; ++m) rsv[ai][m] = rsl[ai * HALF + wr * 64 + m * 16 + fr];
#pragma unroll
        for (int ai = 0; ai < 2; ++ai)
#pragma unroll
            for (int m = 0; m < 4; ++m) {
                bf16_t* rowp = G + (size_t)(row0 + ai * HALF + m * 16) * FF + col0; const float rs = rsv[ai][m];
                const f32x4 g0 = acc[ai][0][m][0] * rs, g1 = acc[ai][0][m][1] * rs, u0 = acc[ai][1][m][0] * rs, u1 = acc[ai][1][m][1] * rs;
                u32x4 w;
                w.x = cvt_pk_bf16(silu_f(g0[0]) * u0[0], silu_f(g0[1]) * u0[1]); w.y = cvt_pk_bf16(silu_f(g0[2]) * u0[2], silu_f(g0[3]) * u0[3]);
                w.z = cvt_pk_bf16(silu_f(g1[0]) * u1[0], silu_f(g1[1]) * u1[1]); w.w = cvt_pk_bf16(silu_f(g1[2]) * u1[2], silu_f(g1[3]) * u1[3]);
                *(u32x4*)rowp = w;
            }
    }
};
template <bool SCALED> struct EpiRowSsqT {
    static constexpr bool PERM = true;
    bf16_t* F; float* SSQ; const float* RS = nullptr;
    static constexpr bool USES_RS = SCALED;
    __device__ __forceinline__ void operator()(const Acc& acc, const Unit& u, int wr, int wc, int fr, int fq, const LAS float* rsl) const {
        const int row0 = u.pm * BM + wr * 64 + fr, col0 = u.pn * BM + wc * 32 + 8 * fq;
        float rsv[2][4];
#pragma unroll
        for (int ai = 0; ai < 2; ++ai)
#pragma unroll
            for (int m = 0; m < 4; ++m) rsv[ai][m] = SCALED ? rsl[ai * HALF + wr * 64 + m * 16 + fr] : 1.0f;
#pragma unroll
        for (int ai = 0; ai < 2; ++ai)
#pragma unroll
            for (int m = 0; m < 4; ++m) {
                const int row = row0 + ai * HALF + m * 16;
                bf16_t* rowp = F + (size_t)row * DM + col0; float s = 0.f;
#pragma unroll
                for (int bj = 0; bj < 2; ++bj) {
                    const f32x4 v0 = acc[ai][bj][m][0] * rsv[ai][m], v1 = acc[ai][bj][m][1] * rsv[ai][m];
                    s += (v0[0] * v0[0] + v0[1] * v0[1]) + (v0[2] * v0[2] + v0[3] * v0[3]) + (v1[0] * v1[0] + v1[1] * v1[1]) + (v1[2] * v1[2] + v1[3] * v1[3]);
                    u32x4 w; w.x = cvt_pk_bf16(v0[0], v0[1]); w.y = cvt_pk_bf16(v0[2], v0[3]); w.z = cvt_pk_bf16(v1[0], v1[1]); w.w = cvt_pk_bf16(v1[2], v1[3]);
                    *(u32x4*)(rowp + bj * HALF) = w;
                }
                s += __shfl_xor(s, 16); s += __shfl_xor(s, 32);
                if (fq == 0) SSQ[(size_t)row * 16 + u.pn * 4 + wc] = s;
            }
    }
};
typedef EpiRowSsqT<false> EpiRowSsq; typedef EpiRowSsqT<true> EpiRowSsqScaled;
struct EpiProj {
    static constexpr bool PERM = true;
    bf16_t* UG; bf16_t* V; const float* RS;
    static constexpr bool USES_RS = true;
    __device__ __forceinline__ void operator()(const Acc& acc, const Unit& u, int wr, int wc, int fr, int fq, const LAS float* rsl) const {
        const int row0 = u.pm * BM + wr * 64 + fr;
        float rsv[2][4];
#pragma unroll
        for (int ai = 0; ai < 2; ++ai)
#pragma unroll
            for (int m = 0; m < 4; ++m) rsv[ai][m] = rsl[ai * HALF + wr * 64 + m * 16 + fr];
#pragma unroll
        for (int ai = 0; ai < 2; ++ai)
#pragma unroll
            for (int m = 0; m < 4; ++m) {
                const int row = row0 + ai * HALF + m * 16; const float rs = rsv[ai][m];
#pragma unroll
                for (int bj = 0; bj < 2; ++bj) {
                    const int c0 = u.pn * BM + bj * HALF + wc * 32 + 8 * fq;
                    const f32x4 v0 = acc[ai][bj][m][0] * rs, v1 = acc[ai][bj][m][1] * rs;
                    u32x4 w; w.x = cvt_pk_bf16(v0[0], v0[1]); w.y = cvt_pk_bf16(v0[2], v0[3]); w.z = cvt_pk_bf16(v1[0], v1[1]); w.w = cvt_pk_bf16(v1[2], v1[3]);
                    bf16_t* dst;
                    if (u.pn < 2) { const int g = c0 >> 4, ch0 = c0 & 15, chunk = row >> 6, t = row & 63; dst = UG + ((size_t)(g * NCHUNK + chunk) * KY + 128 + t * 16 + ch0); }
                    else dst = V + (size_t)(row + 16 * ((row >> 13) + 1)) * 512 + (c0 - 512);
                    *(u32x4*)dst = w;
                }
            }
    }
};
struct EpiS {
    static constexpr bool PERM = false;
    float* S;
    static constexpr bool USES_RS = false; const float* RS = nullptr;
    __device__ __forceinline__ void operator()(const Acc& acc, const Unit& u, int wr, int wc, int fr, int fq, const LAS float* rsl) const {
        const int row0 = u.pm * BM + wr * 64 + fr, col0 = wc * 32 + 4 * fq;
#pragma unroll
        for (int ai = 0; ai < 2; ++ai)
#pragma unroll
            for (int m = 0; m < 4; ++m) {
                float* rowp = S + (u.kofs ? (size_t)32 * NCHUNK * 128 : (size_t)0) + ((size_t)u.g * NCHUNK + row0 + ai * HALF + m * 16) * 128 + col0;
#pragma unroll
                for (int n = 0; n < 2; ++n) *(f32x4*)(rowp + n * 16) = acc[ai][0][m][n];
            }
    }
};
struct EpiY {
    static constexpr bool PERM = false;
    const float* wglu; bf16_t* OS; float* SSQS;
    static constexpr bool USES_RS = false; const float* RS = nullptr;
    __device__ __forceinline__ void operator()(const Acc& acc, const Unit& u, int wr, int wc, int fr, int fq, const LAS float* rsl) const {
        const float* wp = wglu + ((size_t)u.g * 16 + 4 * fq) * 32 + fr;
        bf16x4 wv, wg;
        { float wl[8];
#pragma unroll
          for (int q = 0; q < 8; ++q) wl[q] = wp[16 * q];
          const unsigned a0 = cvt_pk_bf16(wl[0], wl[2]), a1 = cvt_pk_bf16(wl[4], wl[6]); wv[0] = (short)(a0 & 0xffff); wv[1] = (short)(a0 >> 16); wv[2] = (short)(a1 & 0xffff); wv[3] = (short)(a1 >> 16);
          const unsigned b0 = cvt_pk_bf16(wl[1], wl[3]), b1 = cvt_pk_bf16(wl[5], wl[7]); wg[0] = (short)(b0 & 0xffff); wg[1] = (short)(b0 >> 16); wg[2] = (short)(b1 & 0xffff); wg[3] = (short)(b1 >> 16); }
#pragma unroll
        for (int ai = 0; ai < 2; ++ai)
#pragma unroll
            for (int m = 0; m < 4; ++m) {
                const int chunk = u.pm * BM + ai * HALF + wr * 64 + m * 16 + fr;
#pragma unroll
                for (int bj = 0; bj < 2; ++bj)
#pragma unroll
                    for (int n = 0; n < 2; ++n) {
                        const f32x4 a = acc[ai][bj][m][n];
                        const unsigned p0 = cvt_pk_bf16(gelu_tanh_f(a[0]), gelu_tanh_f(a[1])), p1 = cvt_pk_bf16(gelu_tanh_f(a[2]), gelu_tanh_f(a[3]));
                        bf16x4 gy; gy[0] = (short)(p0 & 0xffff); gy[1] = (short)(p0 >> 16); gy[2] = (short)(p1 & 0xffff); gy[3] = (short)(p1 >> 16);
                        const f32x4 z0 = {0.f, 0.f, 0.f, 0.f};
                        const f32x4 zv = __builtin_amdgcn_mfma_f32_16x16x16bf16_1k(wv, gy, z0, 0, 0, 0);
                        const f32x4 zg = __builtin_amdgcn_mfma_f32_16x16x16bf16_1k(wg, gy, z0, 0, 0, 0);
                        const float o0 = zv[0] * fast_sigmoid(zg[0]), o1 = zv[1] * fast_sigmoid(zg[1]), o2 = zv[2] * fast_sigmoid(zg[2]), o3 = zv[3] * fast_sigmoid(zg[3]);
                        const int t = u.pn * 16 + bj * 8 + wc * 2 + n; const size_t token = (size_t)chunk * 64 + t;
                        u32x2 w; w.x = cvt_pk_bf16(o0, o1); w.y = cvt_pk_bf16(o2, o3);
                        *(u32x2*)(OS + token * DM + u.g * 16 + 4 * fq) = w;
                        float s = (o0 * o0 + o1 * o1) + (o2 * o2 + o3 * o3);
                        s += __shfl_xor(s, 16); s += __shfl_xor(s, 32);
                        if (fq == 0) SSQS[((size_t)(u.g * 4 + u.pn) * NCHUNK + chunk) * 16 + (t & 15)] = s;
                    }
            }
    }
};

template <class Epi, class Sched>
__device__ __forceinline__ void gemm_phase(LAS unsigned char* lds, const Gemm g, const Sched& S, const Epi& E) {
    int tid = threadIdx.x; asm volatile("" : "+v"(tid));
    const int wid = __builtin_amdgcn_readfirstlane(tid >> 6), lane = tid & 63, wr = wid >> 2, wc = wid & 3, fr = lane & 15, fq = lane >> 4;
    const int ntK = g.K / BK;
    unsigned voffA[2], voffB[2];
#pragma unroll
    for (int i = 0; i < 2; ++i) { int R, C; stage_rc(tid * 16 + i * 8192, R, C); const int Rb = Epi::PERM ? ((R & ~31) + perm32(R & 31)) : R;
        voffA[i] = (unsigned)(R * g.lda + C) * 2u; voffB[i] = (unsigned)(Rb * g.ldb + C) * 2u; }
    const size_t kstep = (size_t)(BK * 2);
    const size_t hstepA = (size_t)HALF * g.lda * 2, hstepB = (size_t)HALF * g.ldb * 2;
    const size_t tstepA = 2 * hstepA, tstepB = 2 * hstepB;
    const unsigned ldsw = (unsigned)wid * 1024u;
    const int aoff = lds_byte(wr * 64 + fr, fq * 8), boff = lds_byte(wc * 32 + fr, fq * 8);
#define PG8_SA(b, h) (((b) * 2 + (h)) * HTB)
#define PG8_SB(b, h) ((4 + (b) * 2 + (h)) * HTB)
#define PG8_STAGE(bufoff, gbase, voff) do { _Pragma("unroll") for (int _i = 0; _i < 2; ++_i) \
        __builtin_amdgcn_global_load_lds((const unsigned*)((const char*)(gbase) + (voff)[_i]), (LAS unsigned*)(lds + (bufoff) + ldsw + _i * 8192), 16, 0, 0); } while (0)
#define PG8_LDA(dst, b, h) do { _Pragma("unroll") for (int m = 0; m < 4; ++m) _Pragma("unroll") for (int k = 0; k < 2; ++k) dst[m][k] = *(const LAS bf16x8*)(lds + PG8_SA(b, h) + aoff + m * 2048 + k * 1024); } while (0)
#define PG8_LDB(dst, b, h) do { _Pragma("unroll") for (int n = 0; n < 2; ++n) _Pragma("unroll") for (int k = 0; k < 2; ++k) dst[n][k] = *(const LAS bf16x8*)(lds + PG8_SB(b, h) + boff + n * 2048 + k * 1024); } while (0)
#define PG8_MMA(ai, bj, At, Bt) do { __builtin_amdgcn_s_setprio(1); _Pragma("unroll") for (int m = 0; m < 4; ++m) _Pragma("unroll") for (int n = 0; n < 2; ++n) _Pragma("unroll") for (int k = 0; k < 2; ++k) \
        acc[ai][bj][m][n] = __builtin_amdgcn_mfma_f32_16x16x32_bf16(Bt[n][k], At[m][k], acc[ai][bj][m][n], 0, 0, 0); __builtin_amdgcn_s_setprio(0); } while (0)
#define PG8_WAIT_V(n) asm volatile("s_waitcnt vmcnt(" #n ")" ::: "memory")
#define PG8_WAIT_L(n) asm volatile("s_waitcnt lgkmcnt(" #n ")" ::: "memory")
#define PG8_BAR __builtin_amdgcn_s_barrier()
#define PG8_SCHED __builtin_amdgcn_sched_barrier(0)
    Unit cur, nxt; int ui = 0;
    if (!S.next(0, cur)) return;
    Acc acc;
#pragma unroll
    for (int a = 0; a < 2; ++a)
#pragma unroll
        for (int b = 0; b < 2; ++b)
#pragma unroll
            for (int m = 0; m < 4; ++m)
#pragma unroll
                for (int n = 0; n < 2; ++n) acc[a][b][m][n] = (f32x4){0.f, 0.f, 0.f, 0.f};
    bf16x8 At[4][2], B0[2][2], B1[2][2];
    int nt = cur.nt ? cur.nt : ntK;
    LAS float* rstab = (LAS float*)(lds + STAGE_BYTES + 1024);
    if constexpr (Epi::USES_RS) { if (wid == 0) __builtin_amdgcn_global_load_lds((const unsigned*)(E.RS + (size_t)cur.pm * BM + lane * 4), (LAS unsigned*)(rstab), 16, 0, 0); }
    const char* cA = (const char*)g.A + (size_t)cur.g * g.gsA + (size_t)cur.pm * tstepA + cur.kofs + cur.kofsA;
    const char* cB = (const char*)g.Bt + (size_t)cur.g * g.gsB + (size_t)cur.pn * tstepB + cur.kofs;
    PG8_STAGE(PG8_SB(0, 0), cB, voffB); PG8_STAGE(PG8_SA(0, 0), cA, voffA); PG8_STAGE(PG8_SB(0, 1), cB + hstepB, voffB); PG8_STAGE(PG8_SA(0, 1), cA + hstepA, voffA);
    if (wr == 1) PG8_BAR;
    PG8_WAIT_V(4); PG8_BAR;
    PG8_STAGE(PG8_SB(1, 0), cB + kstep, voffB); PG8_STAGE(PG8_SA(1, 0), cA + kstep, voffA); PG8_STAGE(PG8_SB(1, 1), cB + hstepB + kstep, voffB);
    PG8_WAIT_V(6); PG8_BAR;
    for (;;) {
        const bool has_next = S.next(ui + 1, nxt);
        const char* nA = has_next ? (const char*)g.A + (size_t)nxt.g * g.gsA + (size_t)nxt.pm * tstepA + nxt.kofs + nxt.kofsA : cA;
        const char* nB = has_next ? (const char*)g.Bt + (size_t)nxt.g * g.gsB + (size_t)nxt.pn * tstepB + nxt.kofs : cB;
        for (int t = 0; t < nt; t += 2) {
            const bool last = (t == nt - 2);
            const char* a1 = cA + (size_t)(t + 1) * kstep;
            const char* a2 = last ? nA : cA + (size_t)(t + 2) * kstep; const char* b2 = last ? nB : cB + (size_t)(t + 2) * kstep;
            const char* a3 = a2 + kstep; const char* b3 = b2 + kstep;
            PG8_LDB(B0, 0, 0); PG8_SCHED; PG8_LDA(At, 0, 0); PG8_STAGE(PG8_SA(1, 1), a1 + hstepA, voffA);
            PG8_WAIT_L(8); PG8_BAR; PG8_WAIT_L(0); PG8_MMA(0, 0, At, B0); PG8_BAR; PG8_SCHED;
            PG8_LDB(B1, 0, 1); PG8_STAGE(PG8_SB(0, 0), b2, voffB);
            PG8_BAR; PG8_WAIT_L(0); PG8_MMA(0, 1, At, B1); PG8_BAR;
            PG8_LDA(At, 0, 1); PG8_STAGE(PG8_SA(0, 0), a2, voffA);
            PG8_BAR; PG8_WAIT_L(0); PG8_MMA(1, 0, At, B0); PG8_BAR; PG8_SCHED;
            PG8_STAGE(PG8_SB(0, 1), b2 + hstepB, voffB);
            PG8_WAIT_V(6); PG8_BAR; PG8_MMA(1, 1, At, B1); PG8_BAR;
            PG8_LDB(B0, 1, 0); PG8_SCHED; PG8_LDA(At, 1, 0); PG8_STAGE(PG8_SA(0, 1), a2 + hstepA, voffA);
            PG8_WAIT_L(8); PG8_BAR; PG8_WAIT_L(0); PG8_MMA(0, 0, At, B0); PG8_BAR; PG8_SCHED;
            PG8_LDB(B1, 1, 1); PG8_STAGE(PG8_SB(1, 0), b3, voffB);
            PG8_BAR; PG8_WAIT_L(0); PG8_MMA(0, 1, At, B1); PG8_BAR;
            PG8_LDA(At, 1, 1); PG8_STAGE(PG8_SA(1, 0), a3, voffA);
            PG8_BAR; PG8_WAIT_L(0); PG8_MMA(1, 0, At, B0); PG8_BAR; PG8_SCHED;
            PG8_STAGE(PG8_SB(1, 1), b3 + hstepB, voffB);
            PG8_WAIT_V(6); PG8_BAR; PG8_MMA(1, 1, At, B1); PG8_BAR;
        }
        E(acc, cur, wr, wc, fr, fq, rstab + (ui & 1) * 256);
        if (!has_next) break;
#pragma unroll
        for (int a = 0; a < 2; ++a)
#pragma unroll
            for (int b = 0; b < 2; ++b)
#pragma unroll
                for (int m = 0; m < 4; ++m)
#pragma unroll
                    for (int n = 0; n < 2; ++n) acc[a][b][m][n] = (f32x4){0.f, 0.f, 0.f, 0.f};
        cur = nxt; cA = nA; cB = nB; ++ui; nt = cur.nt ? cur.nt : ntK;
        if constexpr (Epi::USES_RS) { if (wid == 0) __builtin_amdgcn_global_load_lds((const unsigned*)(E.RS + (size_t)cur.pm * BM + lane * 4), (LAS unsigned*)(rstab + (ui & 1) * 256), 16, 0, 0); }
    }
    PG8_WAIT_V(0);
    if (wr == 0) PG8_BAR;
    PG8_BAR;
#undef PG8_SA
#undef PG8_SB
#undef PG8_STAGE
#undef PG8_LDA
#undef PG8_LDB
#undef PG8_MMA
#undef PG8_WAIT_V
#undef PG8_WAIT_L
#undef PG8_BAR
#undef PG8_SCHED
}

__device__ __forceinline__ f32x4 meta_tile(const bf16_t* A, const bf16_t* Brow0, int K, int ldb, int lane) {
    const int fr = lane & 15, fq = lane >> 4;
    const bf16_t* ap = A + (size_t)fr * K + fq * 8; const bf16_t* bp = Brow0 + (size_t)fr * ldb + fq * 8;
    f32x4 acc = {0.f, 0.f, 0.f, 0.f};
#pragma unroll 4
    for (int k = 0; k < K; k += 32) {
        const bf16x8 a = *(const bf16x8*)(ap + k), b = *(const bf16x8*)(bp + k);
        acc = __builtin_amdgcn_mfma_f32_16x16x32_bf16(b, a, acc, 0, 0, 0);
    }
    return acc;
}

__device__ __forceinline__ f32x4 meta_tile_split(const bf16_t* A, const bf16_t* Brow0, int K, int ldb, int lane, int wave, LAS f32x4* red) {
    const int fr = lane & 15, fq = lane >> 4, k0 = wave * (K >> 3), k1 = k0 + (K >> 3);
    const bf16_t* ap = A + (size_t)fr * K + fq * 8; const bf16_t* bp = Brow0 + (size_t)fr * ldb + fq * 8;
    f32x4 acc = {0.f, 0.f, 0.f, 0.f};
#pragma unroll 4
    for (int k = k0; k < k1; k += 32) {
        const bf16x8 a = *(const bf16x8*)(ap + k), b = *(const bf16x8*)(bp + k);
        acc = __builtin_amdgcn_mfma_f32_16x16x32_bf16(b, a, acc, 0, 0, 0);
    }
    red[wave * 64 + lane] = acc;
    asm volatile("s_waitcnt lgkmcnt(0)" ::: "memory"); __syncthreads();
    f32x4 t = {0.f, 0.f, 0.f, 0.f};
    if (wave == 0) {
#pragma unroll
        for (int w = 0; w < 8; ++w) t += red[w * 64 + lane];
    }
    __syncthreads();
    return t;
}

__device__ __forceinline__ void transpose_item(const float* W, int N, bf16_t* WT, int ldt, int dst_row0, LAS float* scr, int k0, int n0, int lane, const float* gk = nullptr) {
#pragma unroll
    for (int i = 0; i < 32; ++i) { const int kk = 2 * i + (lane >> 5); scr[kk * 33 + (lane & 31)] = W[(size_t)(k0 + kk) * N + n0 + (lane & 31)] * (gk ? gk[k0 + kk] : 1.0f); }
    asm volatile("s_waitcnt lgkmcnt(0)" ::: "memory");
    const int c = lane & 7;
#pragma unroll
    for (int j = 0; j < 4; ++j) { const int n = (lane >> 3) + 8 * j; const LAS float* s = scr + (8 * c) * 33 + n;
        u32x4 o; o.x = cvt_pk_bf16(s[0 * 33], s[1 * 33]); o.y = cvt_pk_bf16(s[2 * 33], s[3 * 33]); o.z = cvt_pk_bf16(s[4 * 33], s[5 * 33]); o.w = cvt_pk_bf16(s[6 * 33], s[7 * 33]);
        *(u32x4*)(WT + (size_t)(dst_row0 + n) * ldt + k0 + 8 * c) = o; }
    asm volatile("s_waitcnt lgkmcnt(0)" ::: "memory");
}

__device__ __forceinline__ void rms_row_to_bf16(const float* xrow, const float* gain, bf16_t* orow, int lane) {
    const f32x4* xr = (const f32x4*)xrow + lane; f32x4 v[4]; float s = 0.f;
#pragma unroll
    for (int j = 0; j < 4; ++j) { v[j] = xr[64 * j]; s += (v[j][0] * v[j][0] + v[j][1] * v[j][1]) + (v[j][2] * v[j][2] + v[j][3] * v[j][3]); }
    const float r = rsq(wave_sum(s) * (1.f / DM) + EPS);
    u32x2* o = (u32x2*)orow + lane;
#pragma unroll
    for (int j = 0; j < 4; ++j) { const f32x4 gq = gain ? ((const f32x4*)gain)[lane + 64 * j] : (f32x4){1.f, 1.f, 1.f, 1.f}; u32x2 w; w.x = cvt_pk_bf16(v[j][0] * r * gq[0], v[j][1] * r * gq[1]); w.y = cvt_pk_bf16(v[j][2] * r * gq[2], v[j][3] * r * gq[3]); o[64 * j] = w; }
}

template <bool XN_OUT, bool HIN_BF, bool HOUT_BF>
__device__ __forceinline__ void resid_rows(const void* hin_, const bf16_t* F, const float* SSQ, float coef, const float* gpost, void* hout_, float* RS, int gw, int ngw, int lane) {
    constexpr int R = 8;
    f32x4 gp[4];
#pragma unroll
    for (int j = 0; j < 4; ++j) gp[j] = ((const f32x4*)gpost)[lane + 64 * j];
    const int rpw = (MTOK + ngw - 1) / ngw, mbeg = gw * rpw, mend = (mbeg + rpw < MTOK) ? mbeg + rpw : MTOK;
    for (int m0 = mbeg; m0 < mend; m0 += R) {
        u32x2 v[R][4]; u32x2 fw[R][4]; float sqv[R];
#pragma unroll
        for (int r = 0; r < R; ++r) {
            const int m = (m0 + r < mend) ? m0 + r : m0;
            sqv[r] = SSQ[(size_t)m * 16 + (lane & 15)];
#pragma unroll
            for (int j = 0; j < 4; ++j) {
                static_assert(HIN_BF, "the residual stream is stored as bf16");
                v[r][j] = ((const u32x2*)((const bf16_t*)hin_ + (size_t)m * DM))[lane + 64 * j];
                fw[r][j] = ((const u32x2*)(F + (size_t)m * DM))[lane + 64 * j];
            }
        }
#pragma unroll
        for (int r = 0; r < R; ++r) {
            const int m = m0 + r;
            if (m < mend) {
                float ss = sqv[r]; ss += __shfl_xor(ss, 1); ss += __shfl_xor(ss, 2); ss += __shfl_xor(ss, 4); ss += __shfl_xor(ss, 8);
                const float r1 = rsq(ss * (1.f / DM) + EPS) * coef;
                f32x4 h[4]; float s2 = 0.f;
#pragma unroll
                for (int j = 0; j < 4; ++j) {
                    f32x4 vv;
                    { const unsigned w0 = v[r][j].x, w1 = v[r][j].y; vv[0] = bf_lo(w0); vv[1] = bf_hi(w0); vv[2] = bf_lo(w1); vv[3] = bf_hi(w1); }
                    f32x4 f; f[0] = bf_lo(fw[r][j].x); f[1] = bf_hi(fw[r][j].x); f[2] = bf_lo(fw[r][j].y); f[3] = bf_hi(fw[r][j].y);
                    h[j] = vv + r1 * f * gp[j];
                    s2 += (h[j][0] * h[j][0] + h[j][1] * h[j][1]) + (h[j][2] * h[j][2] + h[j][3] * h[j][3]);
                    if (HOUT_BF) { u32x2 w; w.x = cvt_pk_bf16(h[j][0], h[j][1]); w.y = cvt_pk_bf16(h[j][2], h[j][3]); ((u32x2*)((bf16_t*)hout_ + (size_t)m * DM))[lane + 64 * j] = w; }
                    else ((f32x4*)((float*)hout_ + (size_t)m * DM))[lane + 64 * j] = h[j];
                }
                if (XN_OUT) { const float r2 = rsq(wave_sum(s2) * (1.f / DM) + EPS); if (lane == 0) RS[m] = r2; }
            }
        }
    }
}

#define XB_TMO      128
#define XB_XCNT(j)  (256  + 64 * (j))
#define XB_XSUB(j)  (1280 + 64 * (j))
#define XB_XGEN(j)  (2304 + 64 * (j))
#define XB_TOP      3328
#define XB_TOPGEN   3392
#define XCD_BAR_WORDS 3456
#define XB_RANK(j)  (3520 + 64 * (j))
#define CTL_ZERO_BYTES 16384
#define XB_SPIN_CAP (1u << 22)
__device__ __forceinline__ unsigned xb_ld(unsigned* p)              { return __hip_atomic_load(p, __ATOMIC_RELAXED, __HIP_MEMORY_SCOPE_AGENT); }
__device__ __forceinline__ unsigned xb_add(unsigned* p, unsigned v) { return __hip_atomic_fetch_add(p, v, __ATOMIC_RELAXED, __HIP_MEMORY_SCOPE_AGENT); }
__device__ __forceinline__ unsigned xb_xcc_id() { return (unsigned)__builtin_amdgcn_s_getreg((3 << 11) | 20) & 0xFu; }
#define XB_SPIN(cond, bar) do { unsigned _sp = 0; while (cond) { __builtin_amdgcn_s_sleep(1); \
    if ((++_sp & 255u) == 0u) { if (xb_ld(&(bar)[XB_TMO])) break; if (_sp > XB_SPIN_CAP) { atomicAdd(&(bar)[XB_TMO], 1u); break; } } } } while (0)
struct XcdBarrier { unsigned* bar; unsigned x; volatile LAS unsigned* st; };
__device__ __forceinline__ XcdBarrier xcd_barrier_post(unsigned* bar, volatile LAS unsigned* st) {
    XcdBarrier b; b.bar = bar; b.x = xb_xcc_id(); b.st = st;
    if (threadIdx.x == 0) (void)xb_add(&bar[XB_XCNT(b.x)], 1u);
    return b;
}
__device__ __forceinline__ void xcd_barrier_complete(unsigned* bar, unsigned x, unsigned& nloc, unsigned& nx) {
    const unsigned G = gridDim.x * gridDim.y * gridDim.z;
    unsigned sum, cnt, mine, sp = 0u;
    for (;;) {
        sum = 0u; cnt = 0u; mine = 0u;
#pragma unroll
        for (unsigned j = 0; j < 16; ++j) { const unsigned c = xb_ld(&bar[XB_XCNT(j)]); sum += c; cnt += (c > 0u) ? 1u : 0u; mine = (j == x) ? c : mine; }
        if (sum == G) break;
        __builtin_amdgcn_s_sleep(1);
        if ((++sp & 255u) == 0u) { if (xb_ld(&bar[XB_TMO])) break; if (sp > XB_SPIN_CAP) { atomicAdd(&bar[XB_TMO], 1u); break; } }
    }
    nloc = mine > 0u ? mine : 1u; nx = cnt > 0u ? cnt : 1u;
}
__device__ __forceinline__ void xcd_barrier(const XcdBarrier& b) {
    asm volatile("s_waitcnt vmcnt(0)" ::: "memory");
    __syncthreads();
    if (threadIdx.x == 0) {
        unsigned* bar = b.bar;
        __builtin_amdgcn_s_waitcnt(0);
        unsigned nloc = b.st[0], nx = b.st[1];
        if (nloc == 0u) { xcd_barrier_complete(bar, b.x, nloc, nx); b.st[0] = nloc; b.st[1] = nx; }
        const unsigned old = xb_add(&bar[XB_XSUB(b.x)], 1u);
        const unsigned gen = old / nloc;
        if (old + 1u == (gen + 1u) * nloc) {
            __builtin_amdgcn_fence(__ATOMIC_RELEASE, "agent");
            asm volatile("s_waitcnt vmcnt(0)" ::: "memory");
            const unsigned og = xb_add(&bar[XB_TOP], 1u);
            const unsigned tg = og / nx;
            if (og + 1u == (tg + 1u) * nx) xb_add(&bar[XB_TOPGEN], 1u);
            else XB_SPIN(xb_ld(&bar[XB_TOPGEN]) == tg, bar);
            __builtin_amdgcn_fence(__ATOMIC_ACQUIRE, "agent");
            xb_add(&bar[XB_XGEN(b.x)], 1u);
            asm volatile("s_waitcnt vmcnt(0)" ::: "memory");
        } else {
            XB_SPIN(xb_ld(&bar[XB_XGEN(b.x)]) == gen, bar);
            __builtin_amdgcn_fence(__ATOMIC_ACQUIRE, "agent");
            asm volatile("s_waitcnt vmcnt(0)" ::: "memory");
        }
    }
    __syncthreads();
}


#define GRID_SYNC() xcd_barrier(bar)
__global__ void __launch_bounds__(NTHREADS, 2) hymba_fwd(Params p) {
    extern __shared__ __attribute__((aligned(16))) unsigned char lds_raw[];
    LAS unsigned char* lds = (LAS unsigned char*)lds_raw;
    cg::grid_group grid = cg::this_grid();
    const int tid = threadIdx.x, lane = tid & 63, wave = __builtin_amdgcn_readfirstlane(tid >> 6);
    const int G = gridDim.x, blk = blockIdx.x;
    const int gw = blk * NWAVES + wave, ngw = G * NWAVES;
    const int gt = blk * NTHREADS + tid, ngt = G * NTHREADS;
    unsigned char* ws = p.ws;
    const float* x = p.in[0]; const float* meta = p.in[1];
    SsmP sp; sp.lre = p.in[10]; sp.lim = p.in[11]; sp.logdt = p.in[12]; sp.bre = p.in[13]; sp.bim = p.in[14]; sp.cre = p.in[15]; sp.cim = p.in[16]; sp.dskip = p.in[17]; sp.wglu = p.in[18];
    bf16_t* Wgu1 = (bf16_t*)(ws + WS_WGU1); bf16_t* Wd1 = (bf16_t*)(ws + WS_WD1); bf16_t* Wgu2 = (bf16_t*)(ws + WS_WGU2); bf16_t* Wd2 = (bf16_t*)(ws + WS_WD2);
    bf16_t* Win = (bf16_t*)(ws + WS_WIN); bf16_t* Wout = (bf16_t*)(ws + WS_WOUT); bf16_t* M1 = (bf16_t*)(ws + WS_M1); bf16_t* W2 = (bf16_t*)(ws + WS_W2);
    float* Ktab = (float*)(ws + WS_KTAB);
    bf16_t* xn1m = (bf16_t*)(ws + WS_XN1M); bf16_t* Gm = (bf16_t*)(ws + WS_GM); float* f1m = (float*)(ws + WS_F1M); bf16_t* xn2m = (bf16_t*)(ws + WS_XN2M); float* projm = (float*)(ws + WS_PROJM);
    bf16_t* XN = (bf16_t*)(ws + WS_XN); bf16_t* Fb = (bf16_t*)(ws + WS_F); float* SSQ = (float*)(ws + WS_SSQ); bf16_t* Gbuf = (bf16_t*)(ws + WS_GBUF);
    bf16_t* UG = (bf16_t*)(ws + WS_UG); bf16_t* V = (bf16_t*)(ws + WS_V); bf16_t* OS = (bf16_t*)(ws + WS_OS); float* Sb = (float*)(ws + WS_S); float* SSQS = (float*)(ws + WS_SSQS);
    float* out = p.out; bf16_t* Hb = (bf16_t*)(ws + WS_H); float* EQ = (float*)(ws + WS_EQ); float* EP = (float*)(ws + WS_EP); float* RS = (float*)(ws + WS_RS);
    volatile LAS unsigned* bst = (volatile LAS unsigned*)(lds + STAGE_BYTES);
    if (tid == 0) { bst[0] = 0u; bst[1] = 0u; }
    __syncthreads();
    XcdBarrier bar = xcd_barrier_post((unsigned*)(ws + WS_CTL), bst);
    if (tid == 0) { bst[2] = xb_add((unsigned*)(ws + WS_CTL) + XB_RANK(bar.x), 1u); }
    grid.sync();

    {
        LAS float* scr = (LAS float*)(lds + wave * 16384);
        constexpr int I_GU = (DM / 64) * (FF / 32), I_D = (FF / 64) * (DM / 32), I_IN = (DM / 64) * (512 / 32), I_OUT = (DM / 64) * (DM / 32);
        constexpr int NIT = 4 * I_GU + 2 * I_D + I_IN + I_OUT;
        for (int it = gw; it < NIT; it += ngw) {
            int r = it;
            if (r < 4 * I_GU) {
                const int which = r / I_GU; r -= which * I_GU;
                const float* W = p.in[which == 0 ? 4 : which == 1 ? 5 : which == 2 ? 26 : 27]; bf16_t* WT = which < 2 ? Wgu1 : Wgu2;
                const int nblk = FF / 32, kb = r / nblk, nb = r % nblk, n0 = nb * 32;
                const int drow = 256 * (n0 >> 7) + (n0 & 127) + ((which & 1) ? 128 : 0);
                transpose_item(W, FF, WT, DM, drow, scr, kb * 64, n0, lane, p.in[which < 2 ? 2 : 24]); continue;
            }
            r -= 4 * I_GU;
            if (r < 2 * I_D) {
                const int which = r / I_D; r -= which * I_D;
                const float* W = p.in[which == 0 ? 6 : 28]; bf16_t* WT = which == 0 ? Wd1 : Wd2;
                const int nblk = DM / 32, kb = r / nblk, nb = r % nblk;
                transpose_item(W, DM, WT, FF, nb * 32, scr, kb * 64, nb * 32, lane); continue;
            }
            r -= 2 * I_D;
            if (r < I_IN) { const int nblk = 512 / 32, kb = r / nblk, nb = r % nblk; transpose_item(p.in[9], DM, Win, DM, nb * 32, scr, kb * 64, nb * 32, lane, p.in[7]); continue; }
            r -= I_IN;
            { const int nblk = DM / 32, kb = r / nblk, nb = r % nblk; transpose_item(p.in[23], DM, Wout, DM, nb * 32, scr, kb * 64, nb * 32, lane, kb * 64 < 512 ? p.in[21] : p.in[22] - 512); }
        }
        for (int it = gw; it < 8 * 128; it += ngw) {
            const int db = it >> 7, k0 = (it & 127) * 8, d = db * 64 + lane, gi = d >> 7, dd = d & 127;
            const float* pw = p.in[19] + (size_t)gi * 128 * 128 + dd; const float* wi = p.in[9] + (size_t)k0 * DM + 512 + gi * 128;
            float a[8];
#pragma unroll
            for (int kk = 0; kk < 8; ++kk) a[kk] = 0.f;
#pragma unroll 32
            for (int c = 0; c < 128; ++c) { const float pv = pw[(size_t)c * 128];
#pragma unroll
                for (int kk = 0; kk < 8; ++kk) a[kk] += wi[(size_t)kk * DM + c] * pv; }
            const float sc = p.in[20][d]; const f32x4 gm0 = *(const f32x4*)(p.in[7] + k0), gm1 = *(const f32x4*)(p.in[7] + k0 + 4);
            u32x4 o; o.x = cvt_pk_bf16(a[0] * sc * gm0[0], a[1] * sc * gm0[1]); o.y = cvt_pk_bf16(a[2] * sc * gm0[2], a[3] * sc * gm0[3]); o.z = cvt_pk_bf16(a[4] * sc * gm1[0], a[5] * sc * gm1[1]); o.w = cvt_pk_bf16(a[6] * sc * gm1[2], a[7] * sc * gm1[3]);
            *(u32x4*)(Win + (size_t)(512 + d) * DM + k0) = o;
        }
        for (int it = gw; it < 32 * 64; it += ngw) {
            const int g = it >> 6, tau = it & 63;
            { float er, ei, qr, qi; ssm_apow(sp, g, lane, (float)tau, er, ei); ssm_q(sp, g, lane, qr, qi);
              scr[lane] = er * qr - ei * qi; scr[64 + lane] = er * qi + ei * qr; }
            asm volatile("s_waitcnt lgkmcnt(0)" ::: "memory");
            const int ho = lane >> 2, hq = lane & 3;
            float a0 = 0.f, a1 = 0.f, a2 = 0.f, a3 = 0.f;
#pragma unroll 16
            for (int n = 0; n < 64; ++n) {
                const float fr_ = scr[n], fi_ = scr[64 + n];
                const float cr = sp.cre[(size_t)(g * 16 + ho) * 64 + n], ci = sp.cim[(size_t)(g * 16 + ho) * 64 + n];
                const float wr_ = cr * fr_ - ci * fi_, wi_ = cr * fi_ + ci * fr_;
                const f32x4 br = *(const f32x4*)(sp.bre + (size_t)(g * 64 + n) * 16 + 4 * hq), bi = *(const f32x4*)(sp.bim + (size_t)(g * 64 + n) * 16 + 4 * hq);
                a0 += wr_ * br[0] - wi_ * bi[0]; a1 += wr_ * br[1] - wi_ * bi[1]; a2 += wr_ * br[2] - wi_ * bi[2]; a3 += wr_ * br[3] - wi_ * bi[3];
            }
            if (tau == 0) { const float dv = sp.dskip[g * 16 + ho]; const int j = ho - 4 * hq; if (j == 0) a0 += dv; if (j == 1) a1 += dv; if (j == 2) a2 += dv; if (j == 3) a3 += dv; }
            *(f32x4*)(Ktab + ((size_t)(g * 64 + tau) * 16 + ho) * 16 + 4 * hq) = (f32x4){a0, a1, a2, a3};
            asm volatile("s_waitcnt lgkmcnt(0)" ::: "memory");
        }
        for (int it = gt; it < 32 * 65 * 64; it += ngt) {
            const int n = it & 63, pg = it >> 6, pp = pg % 65, g = pg / 65;
            float er, ei, qr, qi; ssm_apow(sp, g, n, (float)pp, er, ei); ssm_q(sp, g, n, qr, qi);
            *(float2*)(EP + ((size_t)(g * 65 + pp) * 64 + n) * 2) = make_float2(er, ei);
            if (pp < 64) *(float2*)(EQ + ((size_t)(g * 64 + pp) * 64 + n) * 2) = make_float2(er * qr - ei * qi, er * qi + ei * qr);
        }
        {
            const int rpw = (MTOK + ngw - 1) / ngw, mbeg = gw * rpw, mend = (mbeg + rpw < MTOK) ? mbeg + rpw : MTOK;
            for (int m0 = mbeg; m0 < mend; m0 += 8) {
                f32x4 v[8][4];
#pragma unroll
                for (int r = 0; r < 8; ++r) { const int m = (m0 + r < mend) ? m0 + r : m0;
#pragma unroll
                    for (int j = 0; j < 4; ++j) v[r][j] = ((const f32x4*)(x + (size_t)m * DM))[lane + 64 * j]; }
#pragma unroll
                for (int r = 0; r < 8; ++r) { const int m = m0 + r; if (m < mend) {
                    float ss = 0.f;
                    u32x2* o = (u32x2*)(XN + (size_t)m * DM) + lane;
#pragma unroll
                    for (int j = 0; j < 4; ++j) { ss += (v[r][j][0] * v[r][j][0] + v[r][j][1] * v[r][j][1]) + (v[r][j][2] * v[r][j][2] + v[r][j][3] * v[r][j][3]);
                        u32x2 w; w.x = cvt_pk_bf16(v[r][j][0], v[r][j][1]); w.y = cvt_pk_bf16(v[r][j][2], v[r][j][3]); o[64 * j] = w; }
                    const float rr = rsq(wave_sum(ss) * (1.f / DM) + EPS); if (lane == 0) RS[m] = rr; } }
            }
        }
        if (gw < 16) rms_row_to_bf16(meta + (size_t)gw * DM, nullptr, xn1m + (size_t)gw * DM, lane);
    }
    GRID_SYNC();

    int vid = blk;
    { bool even = (G % 8) == 0;
      for (unsigned j = 0; j < 16; ++j) { const unsigned cnt = xb_ld((unsigned*)(ws + WS_CTL) + XB_XCNT(j)); if (cnt != (j < 8 ? (unsigned)(G / 8) : 0u)) even = false; }
      const unsigned rk = bst[2];
      if (even && rk < (unsigned)(G / 8) && bar.x < 8u) vid = (int)(rk * 8u + bar.x); }
    vid = __builtin_amdgcn_readfirstlane(vid);
    {
        for (int it0 = gt; it0 < 32 * 256 * 128; it0 += 4 * ngt) {
            u32x4 ov[4];
#pragma unroll
            for (int u = 0; u < 4; ++u) {
                const int it = it0 + u * ngt; u32x4 o = {0u, 0u, 0u, 0u};
                const int kc = it & 127, row = (it >> 7) & 255, g = (it >> 15) & 31;
                if (it < 32 * 256 * 128 && row < 128) {
                    const int n = row & 63, part = row >> 6, s = kc >> 1, hi0 = (kc & 1) * 8;
                    const float2 f = *(const float2*)(EQ + ((size_t)(g * 64 + (63 - s)) * 64 + n) * 2);
                    const float* br = sp.bre + (size_t)(g * 64 + n) * 16 + hi0; const float* bi = sp.bim + (size_t)(g * 64 + n) * 16 + hi0;
                    const f32x4 b0 = *(const f32x4*)br, b1 = *(const f32x4*)(br + 4), c0 = *(const f32x4*)bi, c1 = *(const f32x4*)(bi + 4);
                    f32x4 v0, v1;
                    if (part == 0) { v0 = f.x * b0 - f.y * c0; v1 = f.x * b1 - f.y * c1; } else { v0 = f.x * c0 + f.y * b0; v1 = f.x * c1 + f.y * b1; }
                    o.x = cvt_pk_bf16(v0[0], v0[1]); o.y = cvt_pk_bf16(v0[2], v0[3]); o.z = cvt_pk_bf16(v1[0], v1[1]); o.w = cvt_pk_bf16(v1[2], v1[3]);
                }
                ov[u] = o;
            }
#pragma unroll
            for (int u = 0; u < 4; ++u) { const int it = it0 + u * ngt; if (it < 32 * 256 * 128) { const int kc = it & 127, row = (it >> 7) & 255, g = it >> 15; *(u32x4*)(W2 + ((size_t)(g * 256 + row) * 1024 + kc * 8)) = ov[u]; } }
        }
        for (int it0 = gt; it0 < 32 * 1024 * 144; it0 += 4 * ngt) {
            u32x4 ov[4];
#pragma unroll
            for (int u = 0; u < 4; ++u) {
                const int it = (it0 + u * ngt < 32 * 1024 * 144) ? it0 + u * ngt : it0; u32x4 o = {0u, 0u, 0u, 0u};
                const int kc = it % 144, rg = it / 144, row = rg & 1023, g = rg >> 10, t = row >> 4, ho = row & 15;
                if (kc >= 16) {
                    const int s = (kc - 16) >> 1, hi0 = (kc & 1) * 8;
                    if (s <= t) { const float* kp = Ktab + ((size_t)(g * 64 + (t - s)) * 16 + ho) * 16 + hi0; const f32x4 k0 = *(const f32x4*)kp, k1 = *(const f32x4*)(kp + 4);
                        o.x = cvt_pk_bf16(k0[0], k0[1]); o.y = cvt_pk_bf16(k0[2], k0[3]); o.z = cvt_pk_bf16(k1[0], k1[1]); o.w = cvt_pk_bf16(k1[2], k1[3]); }
                } else {
                    const int kk = kc * 8, part = kk >> 6, n0 = kk & 63;
                    const float* ep = EP + ((size_t)(g * 65 + t + 1) * 64 + n0) * 2; const float* cr = sp.cre + (size_t)(g * 16 + ho) * 64 + n0; const float* ci = sp.cim + (size_t)(g * 16 + ho) * 64 + n0;
                    float v[8];
#pragma unroll
                    for (int j = 0; j < 8; ++j) { const float er = ep[2 * j], ei = ep[2 * j + 1]; v[j] = part == 0 ? (cr[j] * er - ci[j] * ei) : -(cr[j] * ei + ci[j] * er); }
                    o.x = cvt_pk_bf16(v[0], v[1]); o.y = cvt_pk_bf16(v[2], v[3]); o.z = cvt_pk_bf16(v[4], v[5]); o.w = cvt_pk_bf16(v[6], v[7]);
                }
                ov[u] = o;
            }
#pragma unroll
            for (int u = 0; u < 4; ++u) { const int it = it0 + u * ngt; if (it < 32 * 1024 * 144) { const int kc = it % 144, rg = it / 144, row = rg & 1023, g = rg >> 10; *(u32x4*)(M1 + ((size_t)(g * 1024 + row) * KY + kc * 8)) = ov[u]; } }
        }
        for (int tile = blk; tile < FF / 16; tile += G) {
            const int n0 = tile * 16, grow = 256 * (n0 >> 7) + (n0 & 127), fr = lane & 15, fq = lane >> 4;
            const f32x4 ag = meta_tile_split(xn1m, Wgu1 + (size_t)grow * DM, DM, DM, lane, wave, (LAS f32x4*)lds);
            const f32x4 au = meta_tile_split(xn1m, Wgu1 + (size_t)(grow + 128) * DM, DM, DM, lane, wave, (LAS f32x4*)lds);
            if (wave == 0) { u32x2 w; w.x = cvt_pk_bf16(silu_f(ag[0]) * au[0], silu_f(ag[1]) * au[1]); w.y = cvt_pk_bf16(silu_f(ag[2]) * au[2], silu_f(ag[3]) * au[3]);
                *(u32x2*)(Gm + (size_t)fr * FF + n0 + 4 * fq) = w; }
        }
        Gemm gm{XN, Wgu1, DM, DM, DM, 0, 0}; StaticOrder S; S.init(MTOK, 2 * FF, G, vid); EpiSwiGLU E{Gbuf, RS};
        gemm_phase(lds, gm, S, E);
    }
    GRID_SYNC();

    {
        for (int tile = blk; tile < DM / 16; tile += G) { const int n0 = tile * 16, fr = lane & 15, fq = lane >> 4; const f32x4 a = meta_tile_split(Gm, Wd1 + (size_t)n0 * FF, FF, FF, lane, wave, (LAS f32x4*)lds); if (wave == 0) *(f32x4*)(f1m + (size_t)fr * DM + n0 + 4 * fq) = a; }
        Gemm gm{Gbuf, Wd1, FF, FF, FF, 0, 0}; StaticOrder S; S.init(MTOK, DM, G, vid); EpiRowSsq E{Fb, SSQ};
        gemm_phase(lds, gm, S, E);
    }
    GRID_SYNC();

    {
        resid_rows<true, true, true>(XN, Fb, SSQ, 0.5f, p.in[3], Hb, RS, gw, ngw, lane);
        if (gw < 16) {
            const f32x4* hr = (const f32x4*)(meta + (size_t)gw * DM) + lane; const f32x4* fr4 = (const f32x4*)(f1m + (size_t)gw * DM) + lane;
            f32x4 v[4], f[4]; float s = 0.f;
#pragma unroll
            for (int j = 0; j < 4; ++j) { v[j] = hr[64 * j]; f[j] = fr4[64 * j]; s += (f[j][0] * f[j][0] + f[j][1] * f[j][1]) + (f[j][2] * f[j][2] + f[j][3] * f[j][3]); }
            const float r1 = 0.5f * rsq(wave_sum(s) * (1.f / DM) + EPS); float s2 = 0.f;
#pragma unroll
            for (int j = 0; j < 4; ++j) { const f32x4 gp = ((const f32x4*)p.in[3])[lane + 64 * j]; v[j] = v[j] + r1 * f[j] * gp; s2 += (v[j][0] * v[j][0] + v[j][1] * v[j][1]) + (v[j][2] * v[j][2] + v[j][3] * v[j][3]); }
            const float r2 = rsq(wave_sum(s2) * (1.f / DM) + EPS);
            u32x2* o = (u32x2*)(xn2m + (size_t)gw * DM) + lane;
#pragma unroll
            for (int j = 0; j < 4; ++j) { u32x2 w; w.x = cvt_pk_bf16(v[j][0] * r2, v[j][1] * r2); w.y = cvt_pk_bf16(v[j][2] * r2, v[j][3] * r2); o[64 * j] = w; }
        }
    }
    GRID_SYNC();

    {
        for (int tile = blk; tile < DM / 16; tile += G) { const int n0 = tile * 16, fr = lane & 15, fq = lane >> 4; const f32x4 a = meta_tile_split(xn2m, Win + (size_t)n0 * DM, DM, DM, lane, wave, (LAS f32x4*)lds); if (wave == 0) { *(f32x4*)(projm + (size_t)fr * DM + n0 + 4 * fq) = a;
            if (n0 >= 512) { u32x2 w; w.x = cvt_pk_bf16(a[0], a[1]); w.y = cvt_pk_bf16(a[2], a[3]);
                for (int b = 0; b < 8; ++b) *(u32x2*)(V + ((size_t)b * 8208 + fr) * 512 + (n0 - 512) + 4 * fq) = w; } } }
        Gemm gm{Hb, Win, DM, DM, DM, 0, 0}; StaticOrder S; S.init(MTOK, DM, G, vid); EpiProj E{UG, V, RS};
        gemm_phase(lds, gm, S, E);
    }
    GRID_SYNC();

    {
        Gemm gm{UG, W2, KY, 1024, 512, (size_t)NCHUNK * KY * 2, (size_t)256 * 1024 * 2}; OrderS S{G, vid}; EpiS E{Sb};
        gemm_phase(lds, gm, S, E);
    }
    GRID_SYNC();

    if (wave == 0) {
        for (int it = blk; it < 256; it += G) {
            const int b = it >> 5, g = it & 31, n = lane;
            float ar, ai, qr, qi, a64r, a64i; ssm_apow(sp, g, n, 1.0f, ar, ai); ssm_q(sp, g, n, qr, qi); ssm_apow(sp, g, n, 64.0f, a64r, a64i);
            const float* br = sp.bre + (size_t)(g * 64 + n) * 16; const float* bi = sp.bim + (size_t)(g * 64 + n) * 16;
            float xr = 0.f, xi = 0.f;
            for (int t = 0; t < 16; ++t) {
                const float* up = projm + (size_t)t * DM + g * 16; float sr = 0.f, si = 0.f;
#pragma unroll
                for (int h = 0; h < 16; ++h) { const float uv = up[h]; sr += br[h] * uv; si += bi[h] * uv; }
                const float bur = qr * sr - qi * si, bui = qr * si + qi * sr;
                const float nxr = ar * xr - ai * xi + bur, nxi = ar * xi + ai * xr + bui; xr = nxr; xi = nxi;
            }
            const float* sp0 = Sb + ((size_t)g * NCHUNK + b * 128) * 128 + n; bf16_t* xo = UG + ((size_t)g * NCHUNK + b * 128) * KY + n;
            for (int c0 = 0; c0 < 128; c0 += 32) {
                float svr[32], svi[32];
#pragma unroll
                for (int u = 0; u < 32; ++u) { const float* q0 = sp0 + (size_t)(c0 + u) * 128; const float* q1 = q0 + (size_t)32 * NCHUNK * 128; svr[u] = q0[0] + q1[0]; svi[u] = q0[64] + q1[64]; }
#pragma unroll
                for (int u = 0; u < 32; ++u) {
                    const unsigned pk = cvt_pk_bf16(xr, xi);
                    xo[(size_t)(c0 + u) * KY] = (bf16_t)(pk & 0xffff); xo[(size_t)(c0 + u) * KY + 64] = (bf16_t)(pk >> 16);
                    const float nxr = a64r * xr - a64i * xi + svr[u], nxi = a64r * xi + a64i * xr + svi[u]; xr = nxr; xi = nxi;
                }
            }
        }
    }
    GRID_SYNC();

    {
        Gemm gm{UG, M1, KY, KY, KY, (size_t)NCHUNK * KY * 2, (size_t)1024 * KY * 2}; OrderY S{G, vid}; EpiY E{sp.wglu, XN, SSQS};
        gemm_phase(lds, gm, S, E);

    }
    GRID_SYNC();

    {
        const int wl = 2 << (lane >> 4); const float winv = 1.0f / (float)wl;
        const int rpw = (MTOK + ngw - 1) / ngw, rbeg = gw * rpw, rend = (rbeg + rpw < MTOK) ? rbeg + rpw : MTOK;
        for (int r0 = rbeg; r0 < rend; r0 += 4) {
            const bool fast = (r0 + 3 < rend);
            if (fast) {
                float sq[4]; u32x4 qv[19];
#pragma unroll
                for (int t = 0; t < 4; ++t) { const int r = r0 + t;
                    sq[t] = SSQS[((size_t)((lane & 31) * 4 + ((r & 63) >> 4)) * NCHUNK + (r >> 6)) * 16 + (r & 15)]; }
                const int vr3 = r0 + 3 + 16 * (((r0 + 3) >> 13) + 1);
#pragma unroll
                for (int k = 0; k < 19; ++k) qv[k] = (k < wl + 3) ? *(const u32x4*)(V + (size_t)(vr3 - k) * 512 + 8 * lane) : (u32x4){0u, 0u, 0u, 0u};
#pragma unroll
                for (int t = 0; t < 4; ++t) { const int r = r0 + t;
                    const float irs = sqrtf(wave_sum(sq[t]) * 0.5f * (1.f / 512) + EPS);
                    if (lane == 0) RS[r] = 1.0f / irs;
                    float a[8];
#pragma unroll
                    for (int q = 0; q < 8; ++q) a[q] = 0.f;
#pragma unroll
                    for (int d = 0; d < 16; ++d) { const u32x4 q = qv[d + 3 - t]; const float msk = (d < wl) ? 1.0f : 0.0f;
                        a[0] += msk * bf_lo(q.x); a[1] += msk * bf_hi(q.x); a[2] += msk * bf_lo(q.y); a[3] += msk * bf_hi(q.y); a[4] += msk * bf_lo(q.z); a[5] += msk * bf_hi(q.z); a[6] += msk * bf_lo(q.w); a[7] += msk * bf_hi(q.w); }
                    const u32x4 c = qv[3 - t];
                    const float cur[8] = {bf_lo(c.x), bf_hi(c.x), bf_lo(c.y), bf_hi(c.y), bf_lo(c.z), bf_hi(c.z), bf_lo(c.w), bf_hi(c.w)};
                    float ss = 0.f;
#pragma unroll
                    for (int q = 0; q < 8; ++q) { a[q] = a[q] * winv - cur[q]; ss += a[q] * a[q]; }
                    const float rp = rsq(wave_sum(ss) * (1.f / 512) + EPS);
                    const float sc = rp * irs;
                    u32x4 w2; w2.x = cvt_pk_bf16(a[0] * sc, a[1] * sc); w2.y = cvt_pk_bf16(a[2] * sc, a[3] * sc); w2.z = cvt_pk_bf16(a[4] * sc, a[5] * sc); w2.w = cvt_pk_bf16(a[6] * sc, a[7] * sc);
                    *(u32x4*)(XN + (size_t)r * DM + 512 + 8 * lane) = w2; }
            } else {
                for (int tt = 0; tt < 4; ++tt) { const int r = r0 + tt; if (r >= rend) break;
        const int tl = r & 8191;
        const float irs = sqrtf(wave_sum(SSQS[((size_t)((lane & 31) * 4 + ((r & 63) >> 4)) * NCHUNK + (r >> 6)) * 16 + (r & 15)]) * 0.5f * (1.f / 512) + EPS);
        if (lane == 0) RS[r] = 1.0f / irs;
        {
            const int wlen = 2 << (lane >> 4);
            float a[8], cur[8];
#pragma unroll
            for (int j = 0; j < 8; ++j) { a[j] = 0.f; cur[j] = 0.f; }
            for (int d = 0; d < 16; ++d) {
                if (d < wlen) {
                    float v[8];
                    { const u32x4 q = *(const u32x4*)(V + (size_t)(r + 16 * ((r >> 13) + 1) - d) * 512 + 8 * lane);
                        v[0] = bf_lo(q.x); v[1] = bf_hi(q.x); v[2] = bf_lo(q.y); v[3] = bf_hi(q.y); v[4] = bf_lo(q.z); v[5] = bf_hi(q.z); v[6] = bf_lo(q.w); v[7] = bf_hi(q.w); }
#pragma unroll
                    for (int j = 0; j < 8; ++j) { a[j] += v[j]; if (d == 0) cur[j] = v[j]; }
                }
            }
            const float inv = 1.0f / (float)wlen; float s = 0.f;
#pragma unroll
            for (int j = 0; j < 8; ++j) { a[j] = a[j] * inv - cur[j]; s += a[j] * a[j]; }
            const float rp = rsq(wave_sum(s) * (1.f / 512) + EPS);
            const float sc = rp * irs;
            u32x4 w; w.x = cvt_pk_bf16(a[0] * sc, a[1] * sc); w.y = cvt_pk_bf16(a[2] * sc, a[3] * sc); w.z = cvt_pk_bf16(a[4] * sc, a[5] * sc); w.w = cvt_pk_bf16(a[6] * sc, a[7] * sc);
            *(u32x4*)(XN + (size_t)r * DM + 512 + 8 * lane) = w;
        }
                    }
            }
        }
    }
    GRID_SYNC();

    {
        Gemm gm{XN, Wout, DM, DM, DM, 0, 0}; StaticOrder S; S.init(MTOK, DM, G, vid); EpiRowSsqScaled E{Fb, SSQ, RS};
        gemm_phase(lds, gm, S, E);
    }
    GRID_SYNC();

    resid_rows<true, true, true>(Hb, Fb, SSQ, 1.0f, p.in[8], Hb, RS, gw, ngw, lane);
    GRID_SYNC();

    {
        Gemm gm{Hb, Wgu2, DM, DM, DM, 0, 0}; StaticOrder S; S.init(MTOK, 2 * FF, G, vid); EpiSwiGLU E{Gbuf, RS};
        gemm_phase(lds, gm, S, E);
    }
    GRID_SYNC();
    {
        Gemm gm{Gbuf, Wd2, FF, FF, FF, 0, 0}; StaticOrder S; S.init(MTOK, DM, G, vid); EpiRowSsq E{Fb, SSQ};
        gemm_phase(lds, gm, S, E);
    }
    GRID_SYNC();

    resid_rows<false, true, false>(Hb, Fb, SSQ, 0.5f, p.in[25], out, nullptr, gw, ngw, lane);
}

extern "C" void kernel_launch(void* const* d_in, const int* in_sizes, int n_in, void* d_out, int out_size, void* d_ws, size_t ws_size, hipStream_t stream) {
    constexpr size_t kDynLds = STAGE_BYTES + 4096;
    static int grid_blocks = 0;
    if (!grid_blocks) {
        int dev = 0, cus = 0, per_cu = 0;
        hipGetDevice(&dev);
        hipDeviceGetAttribute(&cus, hipDeviceAttributeMultiprocessorCount, dev);
        hipFuncSetAttribute((const void*)hymba_fwd, hipFuncAttributeMaxDynamicSharedMemorySize, (int)kDynLds);
        hipOccupancyMaxActiveBlocksPerMultiprocessor(&per_cu, (const void*)hymba_fwd, NTHREADS, kDynLds);
        if (per_cu < 1) { fprintf(stderr, "occupancy query returned %d\n", per_cu); per_cu = 1; }
        grid_blocks = cus;
        if (ws_size < WS_END) fprintf(stderr, "workspace too small: %zu < %zu\n", ws_size, (size_t)WS_END);
    }
    (void)hipMemsetAsync((char*)d_ws + WS_CTL, 0, CTL_ZERO_BYTES, stream);
    Params p{};
    for (int i = 0; i < 29; ++i) p.in[i] = (const float*)d_in[i];
    p.out = (float*)d_out; p.ws = (unsigned char*)d_ws;
    void* args[] = {&p};
    hipError_t e = hipLaunchCooperativeKernel((const void*)hymba_fwd, dim3(grid_blocks), dim3(NTHREADS), args, kDynLds, stream);
    if (e != hipSuccess) fprintf(stderr, "cooperative launch failed: %s (grid %d)\n", hipGetErrorString(e), grid_blocks);
}
```

```cpp
#include <hip/hip_runtime.h>
#include <hip/hip_cooperative_groups.h>
#include <cstdio>
namespace cg = cooperative_groups;

#define LAS __attribute__((address_space(3)))
typedef unsigned short bf16_t;
typedef short bf16x8 __attribute__((ext_vector_type(8)));
typedef short bf16x4 __attribute__((ext_vector_type(4)));
typedef float f32x4 __attribute__((ext_vector_type(4)));
typedef unsigned u32x4 __attribute__((ext_vector_type(4)));
typedef unsigned u32x2 __attribute__((ext_vector_type(2)));

constexpr int MTOK = 65536;
constexpr int DM = 1024, FF = 2816, NCHUNK = 1024, KY = 1152;
constexpr float EPS = 1e-6f;
constexpr int NTHREADS = 512, NWAVES = 8;

constexpr size_t al256(size_t x) { return (x + 255) & ~(size_t)255; }
constexpr size_t WS_CTL   = 0;
constexpr size_t WS_WGU1  = 65536;
constexpr size_t SZ_WGU   = (size_t)2 * FF * DM * 2;
constexpr size_t WS_WD1   = WS_WGU1 + SZ_WGU;
constexpr size_t SZ_WD    = (size_t)DM * FF * 2;
constexpr size_t WS_WGU2  = WS_WD1 + SZ_WD;
constexpr size_t WS_WD2   = WS_WGU2 + SZ_WGU;
constexpr size_t WS_WIN   = WS_WD2 + SZ_WD;
constexpr size_t WS_WOUT  = WS_WIN + (size_t)DM * DM * 2;
constexpr size_t WS_M1    = WS_WOUT + (size_t)DM * DM * 2;
constexpr size_t SZ_M1    = (size_t)32 * 1024 * KY * 2;
constexpr size_t WS_W2    = WS_M1 + SZ_M1;
constexpr size_t SZ_W2    = (size_t)32 * 256 * 1024 * 2;
constexpr size_t WS_KTAB  = WS_W2 + SZ_W2;
constexpr size_t SZ_KTAB  = (size_t)32 * 64 * 256 * 4;
constexpr size_t WS_XN1M  = WS_KTAB + SZ_KTAB;
constexpr size_t WS_GM    = WS_XN1M + 16 * DM * 2;
constexpr size_t WS_F1M   = al256(WS_GM + 16 * FF * 2);
constexpr size_t WS_XN2M  = WS_F1M + 16 * DM * 4;
constexpr size_t WS_PROJM = WS_XN2M + 16 * DM * 2;
constexpr size_t WS_XN    = WS_PROJM + 16 * DM * 4;
constexpr size_t WS_F     = WS_XN + (size_t)MTOK * DM * 2;
constexpr size_t WS_SSQ   = WS_F + (size_t)MTOK * DM * 2;
constexpr size_t WS_GBUF  = WS_SSQ + (size_t)MTOK * 16 * 4;
constexpr size_t SZ_GBUF  = (size_t)MTOK * FF * 2;
constexpr size_t WS_UG    = WS_GBUF;
constexpr size_t SZ_UG    = (size_t)32 * 1024 * KY * 2;
constexpr size_t WS_V     = WS_UG + SZ_UG;
constexpr int VROWS = 8 * (8192 + 16);
constexpr size_t WS_S     = WS_V + (size_t)VROWS * 512 * 2;
constexpr size_t WS_END0  = WS_GBUF + SZ_GBUF;
constexpr size_t WS_OS    = WS_END0;
constexpr size_t WS_SSQS  = WS_OS + (size_t)MTOK * 512 * 2;
constexpr size_t WS_H     = WS_SSQS + (size_t)MTOK * 32 * 4;
constexpr size_t WS_EQ    = WS_H + (size_t)MTOK * DM * 2;
constexpr size_t WS_EP    = WS_EQ + (size_t)32 * 64 * 64 * 8;
constexpr size_t WS_RS    = WS_EP + (size_t)32 * 65 * 64 * 8;
constexpr size_t WS_END   = WS_RS + (size_t)MTOK * 4;
static_assert(WS_S + (size_t)2 * 32 * 1024 * 128 * 4 <= WS_END0, "alias region overflow");

struct Params { const float* in[29]; float* out; unsigned char* ws; };

typedef float f32x2c __attribute__((ext_vector_type(2)));
typedef __bf16 bf16x2c __attribute__((ext_vector_type(2)));
__device__ __forceinline__ unsigned cvt_pk_bf16(float lo, float hi) { const f32x2c v = {lo, hi}; const bf16x2c r = __builtin_convertvector(v, bf16x2c); return __builtin_bit_cast(unsigned, r); }
__device__ __forceinline__ float bf_lo(unsigned w) { return __uint_as_float(w << 16); }
__device__ __forceinline__ float bf_hi(unsigned w) { return __uint_as_float(w & 0xffff0000u); }
__device__ __forceinline__ float wave_sum(float v) {
#pragma unroll
    for (int o = 1; o < 64; o <<= 1) v += __shfl_xor(v, o);
    return v;
}
__device__ __forceinline__ float fast_sigmoid(float z) { return __builtin_amdgcn_rcpf(1.0f + __builtin_amdgcn_exp2f(-1.4426950408889634f * z)); }
__device__ __forceinline__ float silu_f(float x) { return x * fast_sigmoid(x); }
__device__ __forceinline__ float gelu_tanh_f(float x) { const float z = 0.7978845608028654f * (x + 0.044715f * x * x * x); return x * fast_sigmoid(2.0f * z); }
__device__ __forceinline__ float rsq(float x) { return 1.0f / sqrtf(x); }

struct SsmP { const float *lre, *lim, *logdt, *bre, *bim, *cre, *cim, *dskip, *wglu; };
__device__ __forceinline__ void ssm_apow(const SsmP& P, int g, int n, float p, float& er, float& ei) {
    const float dt = expf(P.logdt[g]); const float lr = P.lre[g * 64 + n], li = P.lim[g * 64 + n];
    const float mag = expf(lr * dt * p);
    double turns = (double)li * (double)dt * (double)p * 0.15915494309189535;
    turns -= rint(turns);
    const float tf = (float)turns;
    er = mag * __builtin_amdgcn_cosf(tf); ei = mag * __builtin_amdgcn_sinf(tf);
}
__device__ __forceinline__ void ssm_q(const SsmP& P, int g, int n, float& qr, float& qi) {
    const float dt = expf(P.logdt[g]); const float lr = P.lre[g * 64 + n], li = P.lim[g * 64 + n];
    const float em1 = expm1f(lr * dt), decay = 1.0f + em1;
    double turns = (double)li * (double)dt * 0.15915494309189535;
    double t1 = turns - rint(turns); double t2 = turns * 0.5; t2 -= rint(t2);
    const float c = __builtin_amdgcn_cosf((float)t1), s = __builtin_amdgcn_sinf((float)t1), sh = __builtin_amdgcn_sinf((float)t2);
    const float ai = decay * s;
    const float nr = em1 * c - 2.0f * sh * sh;
    const float den = lr * lr + li * li;
    qr = (nr * lr + ai * li) / den; qi = (ai * lr - nr * li) / den;
}

constexpr int BM = 256, BK = 64, HALF = 128, HTB = HALF * BK * 2, STAGE_BYTES = 8 * HTB, NXCD = 8, WGM = 8;
__device__ __forceinline__ int lds_byte(int r, int c) { const int st = (r >> 4) * 2 + (c >> 5), rr = r & 15, cc = c & 31, ob = rr * 64 + cc * 2; return st * 1024 + (ob ^ (((ob >> 9) & 1) << 5)); }
__device__ __forceinline__ void stage_rc(int b, int& R, int& C) { const int st = b / 1024, sb = b % 1024, swz = sb ^ (((sb >> 9) & 1) << 5); R = (st >> 1) * 16 + swz / 64; C = (st & 1) * 32 + (swz % 64) / 2; }
__device__ __forceinline__ int perm32(int rho) { const int n = rho >> 4, i = rho & 15; return 8 * (i >> 2) + 4 * n + (i & 3); }

struct Unit { int pm, pn, g, kofs, kofsA, nt; };
struct Gemm { const bf16_t* A; const bf16_t* Bt; int lda, ldb, K; size_t gsA, gsB; };

struct StaticOrder {
    int nM, nN, nwg, G, c;
    __device__ void init(int M, int N, int G_, int c_) { nM = M / BM; nN = N / BM; nwg = nM * nN; G = G_; c = c_; }
    __device__ bool next(int i, Unit& u) const {
        const long L = (long)i * G + c; if (L >= nwg) return false;
        int wgid = (int)L; { const int q = nwg / NXCD, r = nwg % NXCD, xcd = wgid % NXCD, off = wgid / NXCD; wgid = (xcd < r ? xcd * (q + 1) : r * (q + 1) + (xcd - r) * q) + off; }
        const int nig = WGM * nN, gid = wgid / nig, fm = gid * WGM, gsz = (nM - fm) < WGM ? (nM - fm) : WGM;
        u.pm = fm + ((wgid % nig) % gsz); u.pn = (wgid % nig) / gsz; u.g = 0; u.kofs = 0; u.kofsA = 0; u.nt = 0; return true;
    }
};
struct OrderS {
    int G, c;
    __device__ bool next(int i, Unit& u) const { const int L = i * G + c; if (L >= 256) return false; u.g = L >> 3; u.pm = (L >> 1) & 3; u.pn = 0; u.kofs = (L & 1) * 1024; u.kofsA = 256; u.nt = 0; return true; }
};
struct OrderY {
    int G, c;
    __device__ bool next(int i, Unit& u) const { const int L = i * G + c; if (L >= 512) return false; const int l = L & 255;
        u.g = l >> 3; u.pm = (l >> 1) & 3; u.pn = (L < 256) ? (l & 1) : 3 - (l & 1); u.kofs = 0; u.kofsA = 0; u.nt = 2 + 4 * (u.pn + 1); return true; }
};

typedef f32x4 Acc[2][2][4][2];

struct EpiSwiGLU {
    static constexpr bool PERM = true;
    bf16_t* G; const float* RS;
    static constexpr bool USES_RS = true;
    __device__ __forceinline__ void operator()(const Acc& acc, const Unit& u, int wr, int wc, int fr, int fq, const LAS float* rsl) const {
        const int row0 = u.pm * BM + wr * 64 + fr, col0 = u.pn * 128 + wc * 32 + 8 * fq;
        float rsv[2][4];
#pragma unroll
        for (int ai = 0; ai < 2; ++ai)
#pragma unroll
            for (int m = 0; m < 4; ++m) rsv[ai][m] = rsl[ai * HALF + wr * 64 + m * 16 + fr];
#pragma unroll
        for (int ai = 0; ai < 2; ++ai)
#pragma unroll
            for (int m = 0; m < 4; ++m) {
                bf16_t* rowp = G + (size_t)(row0 + ai * HALF + m * 16) * FF + col0; const float rs = rsv[ai][m];
                const f32x4 g0 = acc[ai][0][m][0] * rs, g1 = acc[ai][0][m][1] * rs, u0 = acc[ai][1][m][0] * rs, u1 = acc[ai][1][m][1] * rs;
                u32x4 w;
                w.x = cvt_pk_bf16(silu_f(g0[0]) * u0[0], silu_f(g0[1]) * u0[1]); w.y = cvt_pk_bf16(silu_f(g0[2]) * u0[2], silu_f(g0[3]) * u0[3]);
                w.z = cvt_pk_bf16(silu_f(g1[0]) * u1[0], silu_f(g1[1]) * u1[1]); w.w = cvt_pk_bf16(silu_f(g1[2]) * u1[2], silu_f(g1[3]) * u1[3]);
                *(u32x4*)rowp = w;
            }
    }
};
template <bool SCALED> struct EpiRowSsqT {
    static constexpr bool PERM = true;
    bf16_t* F; float* SSQ; const float* RS = nullptr;
    static constexpr bool USES_RS = SCALED;
    __device__ __forceinline__ void operator()(const Acc& acc, const Unit& u, int wr, int wc, int fr, int fq, const LAS float* rsl) const {
        const int row0 = u.pm * BM + wr * 64 + fr, col0 = u.pn * BM + wc * 32 + 8 * fq;
        float rsv[2][4];
#pragma unroll
        for (int ai = 0; ai < 2; ++ai)
#pragma unroll
            for (int m = 0; m < 4; ++m) rsv[ai][m] = SCALED ? rsl[ai * HALF + wr * 64 + m * 16 + fr] : 1.0f;
#pragma unroll
        for (int ai = 0; ai < 2; ++ai)
#pragma unroll
            for (int m = 0; m < 4; ++m) {
                const int row = row0 + ai * HALF + m * 16;
                bf16_t* rowp = F + (size_t)row * DM + col0; float s = 0.f;
#pragma unroll
                for (int bj = 0; bj < 2; ++bj) {
                    const f32x4 v0 = acc[ai][bj][m][0] * rsv[ai][m], v1 = acc[ai][bj][m][1] * rsv[ai][m];
                    s += (v0[0] * v0[0] + v0[1] * v0[1]) + (v0[2] * v0[2] + v0[3] * v0[3]) + (v1[0] * v1[0] + v1[1] * v1[1]) + (v1[2] * v1[2] + v1[3] * v1[3]);
                    u32x4 w; w.x = cvt_pk_bf16(v0[0], v0[1]); w.y = cvt_pk_bf16(v0[2], v0[3]); w.z = cvt_pk_bf16(v1[0], v1[1]); w.w = cvt_pk_bf16(v1[2], v1[3]);
                    *(u32x4*)(rowp + bj * HALF) = w;
                }
                s += __shfl_xor(s, 16); s += __shfl_xor(s, 32);
                if (fq == 0) SSQ[(size_t)row * 16 + u.pn * 4 + wc] = s;
            }
    }
};
typedef EpiRowSsqT<false> EpiRowSsq; typedef EpiRowSsqT<true> EpiRowSsqScaled;
struct EpiProj {
    static constexpr bool PERM = true;
    bf16_t* UG; bf16_t* V; const float* RS;
    static constexpr bool USES_RS = true;
    __device__ __forceinline__ void operator()(const Acc& acc, const Unit& u, int wr, int wc, int fr, int fq, const LAS float* rsl) const {
        const int row0 = u.pm * BM + wr * 64 + fr;
        float rsv[2][4];
#pragma unroll
        for (int ai = 0; ai < 2; ++ai)
#pragma unroll
            for (int m = 0; m < 4; ++m) rsv[ai][m] = rsl[ai * HALF + wr * 64 + m * 16 + fr];
#pragma unroll
        for (int ai = 0; ai < 2; ++ai)
#pragma unroll
            for (int m = 0; m < 4; ++m) {
                const int row = row0 + ai * HALF + m * 16; const float rs = rsv[ai][m];
#pragma unroll
                for (int bj = 0; bj < 2; ++bj) {
                    const int c0 = u.pn * BM + bj * HALF + wc * 32 + 8 * fq;
                    const f32x4 v0 = acc[ai][bj][m][0] * rs, v1 = acc[ai][bj][m][1] * rs;
                    u32x4 w; w.x = cvt_pk_bf16(v0[0], v0[1]); w.y = cvt_pk_bf16(v0[2], v0[3]); w.z = cvt_pk_bf16(v1[0], v1[1]); w.w = cvt_pk_bf16(v1[2], v1[3]);
                    bf16_t* dst;
                    if (u.pn < 2) { const int g = c0 >> 4, ch0 = c0 & 15, chunk = row >> 6, t = row & 63; dst = UG + ((size_t)(g * NCHUNK + chunk) * KY + 128 + t * 16 + ch0); }
                    else dst = V + (size_t)(row + 16 * ((row >> 13) + 1)) * 512 + (c0 - 512);
                    *(u32x4*)dst = w;
                }
            }
    }
};
struct EpiS {
    static constexpr bool PERM = false;
    float* S;
    static constexpr bool USES_RS = false; const float* RS = nullptr;
    __device__ __forceinline__ void operator()(const Acc& acc, const Unit& u, int wr, int wc, int fr, int fq, const LAS float* rsl) const {
        const int row0 = u.pm * BM + wr * 64 + fr, col0 = wc * 32 + 4 * fq;
#pragma unroll
        for (int ai = 0; ai < 2; ++ai)
#pragma unroll
            for (int m = 0; m < 4; ++m) {
                float* rowp = S + (u.kofs ? (size_t)32 * NCHUNK * 128 : (size_t)0) + ((size_t)u.g * NCHUNK + row0 + ai * HALF + m * 16) * 128 + col0;
#pragma unroll
                for (int n = 0; n < 2; ++n) *(f32x4*)(rowp + n * 16) = acc[ai][0][m][n];
            }
    }
};
struct EpiY {
    static constexpr bool PERM = false;
    const float* wglu; bf16_t* OS; float* SSQS;
    static constexpr bool USES_RS = false; const float* RS = nullptr;
    __device__ __forceinline__ void operator()(const Acc& acc, const Unit& u, int wr, int wc, int fr, int fq, const LAS float* rsl) const {
        const float* wp = wglu + ((size_t)u.g * 16 + 4 * fq) * 32 + fr;
        bf16x4 wv, wg;
        { float wl[8];
#pragma unroll
          for (int q = 0; q < 8; ++q) wl[q] = wp[16 * q];
          const unsigned a0 = cvt_pk_bf16(wl[0], wl[2]), a1 = cvt_pk_bf16(wl[4], wl[6]); wv[0] = (short)(a0 & 0xffff); wv[1] = (short)(a0 >> 16); wv[2] = (short)(a1 & 0xffff); wv[3] = (short)(a1 >> 16);
          const unsigned b0 = cvt_pk_bf16(wl[1], wl[3]), b1 = cvt_pk_bf16(wl[5], wl[7]); wg[0] = (short)(b0 & 0xffff); wg[1] = (short)(b0 >> 16); wg[2] = (short)(b1 & 0xffff); wg[3] = (short)(b1 >> 16); }
#pragma unroll
        for (int ai = 0; ai < 2; ++ai)
#pragma unroll
            for (int m = 0; m < 4; ++m) {
                const int chunk = u.pm * BM + ai * HALF + wr * 64 + m * 16 + fr;
#pragma unroll
                for (int bj = 0; bj < 2; ++bj)
#pragma unroll
                    for (int n = 0; n < 2; ++n) {
                        const f32x4 a = acc[ai][bj][m][n];
                        const unsigned p0 = cvt_pk_bf16(gelu_tanh_f(a[0]), gelu_tanh_f(a[1])), p1 = cvt_pk_bf16(gelu_tanh_f(a[2]), gelu_tanh_f(a[3]));
                        bf16x4 gy; gy[0] = (short)(p0 & 0xffff); gy[1] = (short)(p0 >> 16); gy[2] = (short)(p1 & 0xffff); gy[3] = (short)(p1 >> 16);
                        const f32x4 z0 = {0.f, 0.f, 0.f, 0.f};
                        const f32x4 zv = __builtin_amdgcn_mfma_f32_16x16x16bf16_1k(wv, gy, z0, 0, 0, 0);
                        const f32x4 zg = __builtin_amdgcn_mfma_f32_16x16x16bf16_1k(wg, gy, z0, 0, 0, 0);
                        const float o0 = zv[0] * fast_sigmoid(zg[0]), o1 = zv[1] * fast_sigmoid(zg[1]), o2 = zv[2] * fast_sigmoid(zg[2]), o3 = zv[3] * fast_sigmoid(zg[3]);
                        const int t = u.pn * 16 + bj * 8 + wc * 2 + n; const size_t token = (size_t)chunk * 64 + t;
                        u32x2 w; w.x = cvt_pk_bf16(o0, o1); w.y = cvt_pk_bf16(o2, o3);
                        *(u32x2*)(OS + token * DM + u.g * 16 + 4 * fq) = w;
                        float s = (o0 * o0 + o1 * o1) + (o2 * o2 + o3 * o3);
                        s += __shfl_xor(s, 16); s += __shfl_xor(s, 32);
                        if (fq == 0) SSQS[((size_t)(u.g * 4 + u.pn) * NCHUNK + chunk) * 16 + (t & 15)] = s;
                    }
            }
    }
};

template <class Epi, class Sched>
__device__ __forceinline__ void gemm_phase(LAS unsigned char* lds, const Gemm g, const Sched& S, const Epi& E) {
    int tid = threadIdx.x; asm volatile("" : "+v"(tid));
    const int wid = __builtin_amdgcn_readfirstlane(tid >> 6), lane = tid & 63, wr = wid >> 2, wc = wid & 3, fr = lane & 15, fq = lane >> 4;
    const int ntK = g.K / BK;
    unsigned voffA[2], voffB[2];
#pragma unroll
    for (int i = 0; i < 2; ++i) { int R, C; stage_rc(tid * 16 + i * 8192, R, C); const int Rb = Epi::PERM ? ((R & ~31) + perm32(R & 31)) : R;
        voffA[i] = (unsigned)(R * g.lda + C) * 2u; voffB[i] = (unsigned)(Rb * g.ldb + C) * 2u; }
    const size_t kstep = (size_t)(BK * 2);
    const size_t hstepA = (size_t)HALF * g.lda * 2, hstepB = (size_t)HALF * g.ldb * 2;
    const size_t tstepA = 2 * hstepA, tstepB = 2 * hstepB;
    const unsigned ldsw = (unsigned)wid * 1024u;
    const int aoff = lds_byte(wr * 64 + fr, fq * 8), boff = lds_byte(wc * 32 + fr, fq * 8);
#define PG8_SA(b, h) (((b) * 2 + (h)) * HTB)
#define PG8_SB(b, h) ((4 + (b) * 2 + (h)) * HTB)
#define PG8_STAGE(bufoff, gbase, voff) do { _Pragma("unroll") for (int _i = 0; _i < 2; ++_i) \
        __builtin_amdgcn_global_load_lds((const unsigned*)((const char*)(gbase) + (voff)[_i]), (LAS unsigned*)(lds + (bufoff) + ldsw + _i * 8192), 16, 0, 0); } while (0)
#define PG8_LDA(dst, b, h) do { _Pragma("unroll") for (int m = 0; m < 4; ++m) _Pragma("unroll") for (int k = 0; k < 2; ++k) dst[m][k] = *(const LAS bf16x8*)(lds + PG8_SA(b, h) + aoff + m * 2048 + k * 1024); } while (0)
#define PG8_LDB(dst, b, h) do { _Pragma("unroll") for (int n = 0; n < 2; ++n) _Pragma("unroll") for (int k = 0; k < 2; ++k) dst[n][k] = *(const LAS bf16x8*)(lds + PG8_SB(b, h) + boff + n * 2048 + k * 1024); } while (0)
#define PG8_MMA(ai, bj, At, Bt) do { __builtin_amdgcn_s_setprio(1); _Pragma("unroll") for (int m = 0; m < 4; ++m) _Pragma("unroll") for (int n = 0; n < 2; ++n) _Pragma("unroll") for (int k = 0; k < 2; ++k) \
        acc[ai][bj][m][n] = __builtin_amdgcn_mfma_f32_16x16x32_bf16(Bt[n][k], At[m][k], acc[ai][bj][m][n], 0, 0, 0); __builtin_amdgcn_s_setprio(0); } while (0)
#define PG8_WAIT_V(n) asm volatile("s_waitcnt vmcnt(" #n ")" ::: "memory")
#define PG8_WAIT_L(n) asm volatile("s_waitcnt lgkmcnt(" #n ")" ::: "memory")
#define PG8_BAR __builtin_amdgcn_s_barrier()
#define PG8_SCHED __builtin_amdgcn_sched_barrier(0)
    Unit cur, nxt; int ui = 0;
    if (!S.next(0, cur)) return;
    Acc acc;
#pragma unroll
    for (int a = 0; a < 2; ++a)
#pragma unroll
        for (int b = 0; b < 2; ++b)
#pragma unroll
            for (int m = 0; m < 4; ++m)
#pragma unroll
                for (int n = 0; n < 2; ++n) acc[a][b][m][n] = (f32x4){0.f, 0.f, 0.f, 0.f};
    bf16x8 At[4][2], B0[2][2], B1[2][2];
    int nt = cur.nt ? cur.nt : ntK;
    LAS float* rstab = (LAS float*)(lds + STAGE_BYTES + 1024);
    if constexpr (Epi::USES_RS) { if (wid == 0) __builtin_amdgcn_global_load_lds((const unsigned*)(E.RS + (size_t)cur.pm * BM + lane * 4), (LAS unsigned*)(rstab), 16, 0, 0); }
    const char* cA = (const char*)g.A + (size_t)cur.g * g.gsA + (size_t)cur.pm * tstepA + cur.kofs + cur.kofsA;
    const char* cB = (const char*)g.Bt + (size_t)cur.g * g.gsB + (size_t)cur.pn * tstepB + cur.kofs;
    PG8_STAGE(PG8_SB(0, 0), cB, voffB); PG8_STAGE(PG8_SA(0, 0), cA, voffA); PG8_STAGE(PG8_SB(0, 1), cB + hstepB, voffB); PG8_STAGE(PG8_SA(0, 1), cA + hstepA, voffA);
    if (wr == 1) PG8_BAR;
    PG8_WAIT_V(4); PG8_BAR;
    PG8_STAGE(PG8_SB(1, 0), cB + kstep, voffB); PG8_STAGE(PG8_SA(1, 0), cA + kstep, voffA); PG8_STAGE(PG8_SB(1, 1), cB + hstepB + kstep, voffB);
    PG8_WAIT_V(6); PG8_BAR;
    for (;;) {
        const bool has_next = S.next(ui + 1, nxt);
        const char* nA = has_next ? (const char*)g.A + (size_t)nxt.g * g.gsA + (size_t)nxt.pm * tstepA + nxt.kofs + nxt.kofsA : cA;
        const char* nB = has_next ? (const char*)g.Bt + (size_t)nxt.g * g.gsB + (size_t)nxt.pn * tstepB + nxt.kofs : cB;
        for (int t = 0; t < nt; t += 2) {
            const bool last = (t == nt - 2);
            const char* a1 = cA + (size_t)(t + 1) * kstep;
            const char* a2 = last ? nA : cA + (size_t)(t + 2) * kstep; const char* b2 = last ? nB : cB + (size_t)(t + 2) * kstep;
            const char* a3 = a2 + kstep; const char* b3 = b2 + kstep;
            PG8_LDB(B0, 0, 0); PG8_SCHED; PG8_LDA(At, 0, 0); PG8_STAGE(PG8_SA(1, 1), a1 + hstepA, voffA);
            PG8_WAIT_L(8); PG8_BAR; PG8_WAIT_L(0); PG8_MMA(0, 0, At, B0); PG8_BAR; PG8_SCHED;
            PG8_LDB(B1, 0, 1); PG8_STAGE(PG8_SB(0, 0), b2, voffB);
            PG8_BAR; PG8_WAIT_L(0); PG8_MMA(0, 1, At, B1); PG8_BAR;
            PG8_LDA(At, 0, 1); PG8_STAGE(PG8_SA(0, 0), a2, voffA);
            PG8_BAR; PG8_WAIT_L(0); PG8_MMA(1, 0, At, B0); PG8_BAR; PG8_SCHED;
            PG8_STAGE(PG8_SB(0, 1), b2 + hstepB, voffB);
            PG8_WAIT_V(6); PG8_BAR; PG8_MMA(1, 1, At, B1); PG8_BAR;
            PG8_LDB(B0, 1, 0); PG8_SCHED; PG8_LDA(At, 1, 0); PG8_STAGE(PG8_SA(0, 1), a2 + hstepA, voffA);
            PG8_WAIT_L(8); PG8_BAR; PG8_WAIT_L(0); PG8_MMA(0, 0, At, B0); PG8_BAR; PG8_SCHED;
            PG8_LDB(B1, 1, 1); PG8_STAGE(PG8_SB(1, 0), b3, voffB);
            PG8_BAR; PG8_WAIT_L(0); PG8_MMA(0, 1, At, B1); PG8_BAR;
            PG8_LDA(At, 1, 1); PG8_STAGE(PG8_SA(1, 0), a3, voffA);
            PG8_BAR; PG8_WAIT_L(0); PG8_MMA(1, 0, At, B0); PG8_BAR; PG8_SCHED;
            PG8_STAGE(PG8_SB(1, 1), b3 + hstepB, voffB);
            PG8_WAIT_V(6); PG8_BAR; PG8_MMA(1, 1, At, B1); PG8_BAR;
        }
        E(acc, cur, wr, wc, fr, fq, rstab + (ui & 1) * 256);
        if (!has_next) break;
#pragma unroll
        for (int a = 0; a < 2; ++a)
#pragma unroll
            for (int b = 0; b < 2; ++b)
#pragma unroll
                for (int m = 0; m < 4; ++m)
#pragma unroll
                    for (int n = 0; n < 2; ++n) acc[a][b][m][n] = (f32x4){0.f, 0.f, 0.f, 0.f};
        cur = nxt; cA = nA; cB = nB; ++ui; nt = cur.nt ? cur.nt : ntK;
        if constexpr (Epi::USES_RS) { if (wid == 0) __builtin_amdgcn_global_load_lds((const unsigned*)(E.RS + (size_t)cur.pm * BM + lane * 4), (LAS unsigned*)(rstab + (ui & 1) * 256), 16, 0, 0); }
    }
    PG8_WAIT_V(0);
    if (wr == 0) PG8_BAR;
    PG8_BAR;
#undef PG8_SA
#undef PG8_SB
#undef PG8_STAGE
#undef PG8_LDA
#undef PG8_LDB
#undef PG8_MMA
#undef PG8_WAIT_V
#undef PG8_WAIT_L
#undef PG8_BAR
#undef PG8_SCHED
}

__device__ __forceinline__ f32x4 meta_tile(const bf16_t* A, const bf16_t* Brow0, int K, int ldb, int lane) {
    const int fr = lane & 15, fq = lane >> 4;
    const bf16_t* ap = A + (size_t)fr * K + fq * 8; const bf16_t* bp = Brow0 + (size_t)fr * ldb + fq * 8;
    f32x4 acc = {0.f, 0.f, 0.f, 0.f};
#pragma unroll 4
    for (int k = 0; k < K; k += 32) {
        const bf16x8 a = *(const bf16x8*)(ap + k), b = *(const bf16x8*)(bp + k);
        acc = __builtin_amdgcn_mfma_f32_16x16x32_bf16(b, a, acc, 0, 0, 0);
    }
    return acc;
}

__device__ __forceinline__ f32x4 meta_tile_split(const bf16_t* A, const bf16_t* Brow0, int K, int ldb, int lane, int wave, LAS f32x4* red) {
    const int fr = lane & 15, fq = lane >> 4, k0 = wave * (K >> 3), k1 = k0 + (K >> 3);
    const bf16_t* ap = A + (size_t)fr * K + fq * 8; const bf16_t* bp = Brow0 + (size_t)fr * ldb + fq * 8;
    f32x4 acc = {0.f, 0.f, 0.f, 0.f};
#pragma unroll 4
    for (int k = k0; k < k1; k += 32) {
        const bf16x8 a = *(const bf16x8*)(ap + k), b = *(const bf16x8*)(bp + k);
        acc = __builtin_amdgcn_mfma_f32_16x16x32_bf16(b, a, acc, 0, 0, 0);
    }
    red[wave * 64 + lane] = acc;
    asm volatile("s_waitcnt lgkmcnt(0)" ::: "memory"); __syncthreads();
    f32x4 t = {0.f, 0.f, 0.f, 0.f};
    if (wave == 0) {
#pragma unroll
        for (int w = 0; w < 8; ++w) t += red[w * 64 + lane];
    }
    __syncthreads();
    return t;
}

__device__ __forceinline__ void transpose_item(const float* W, int N, bf16_t* WT, int ldt, int dst_row0, LAS float* scr, int k0, int n0, int lane, const float* gk = nullptr) {
#pragma unroll
    for (int i = 0; i < 32; ++i) { const int kk = 2 * i + (lane >> 5); scr[kk * 33 + (lane & 31)] = W[(size_t)(k0 + kk) * N + n0 + (lane & 31)] * (gk ? gk[k0 + kk] : 1.0f); }
    asm volatile("s_waitcnt lgkmcnt(0)" ::: "memory");
    const int c = lane & 7;
#pragma unroll
    for (int j = 0; j < 4; ++j) { const int n = (lane >> 3) + 8 * j; const LAS float* s = scr + (8 * c) * 33 + n;
        u32x4 o; o.x = cvt_pk_bf16(s[0 * 33], s[1 * 33]); o.y = cvt_pk_bf16(s[2 * 33], s[3 * 33]); o.z = cvt_pk_bf16(s[4 * 33], s[5 * 33]); o.w = cvt_pk_bf16(s[6 * 33], s[7 * 33]);
        *(u32x4*)(WT + (size_t)(dst_row0 + n) * ldt + k0 + 8 * c) = o; }
    asm volatile("s_waitcnt lgkmcnt(0)" ::: "memory");
}

__device__ __forceinline__ void rms_row_to_bf16(const float* xrow, const float* gain, bf16_t* orow, int lane) {
    const f32x4* xr = (const f32x4*)xrow + lane; f32x4 v[4]; float s = 0.f;
#pragma unroll
    for (int j = 0; j < 4; ++j) { v[j] = xr[64 * j]; s += (v[j][0] * v[j][0] + v[j][1] * v[j][1]) + (v[j][2] * v[j][2] + v[j][3] * v[j][3]); }
    const float r = rsq(wave_sum(s) * (1.f / DM) + EPS);
    u32x2* o = (u32x2*)orow + lane;
#pragma unroll
    for (int j = 0; j < 4; ++j) { const f32x4 gq = gain ? ((const f32x4*)gain)[lane + 64 * j] : (f32x4){1.f, 1.f, 1.f, 1.f}; u32x2 w; w.x = cvt_pk_bf16(v[j][0] * r * gq[0], v[j][1] * r * gq[1]); w.y = cvt_pk_bf16(v[j][2] * r * gq[2], v[j][3] * r * gq[3]); o[64 * j] = w; }
}

template <bool XN_OUT, bool HIN_BF, bool HOUT_BF>
__device__ __forceinline__ void resid_rows(const void* hin_, const bf16_t* F, const float* SSQ, float coef, const float* gpost, void* hout_, float* RS, int gw, int ngw, int lane) {
    constexpr int R = 8;
    f32x4 gp[4];
#pragma unroll
    for (int j = 0; j < 4; ++j) gp[j] = ((const f32x4*)gpost)[lane + 64 * j];
    const int rpw = (MTOK + ngw - 1) / ngw, mbeg = gw * rpw, mend = (mbeg + rpw < MTOK) ? mbeg + rpw : MTOK;
    for (int m0 = mbeg; m0 < mend; m0 += R) {
        u32x2 v[R][4]; u32x2 fw[R][4]; float sqv[R];
#pragma unroll
        for (int r = 0; r < R; ++r) {
            const int m = (m0 + r < mend) ? m0 + r : m0;
            sqv[r] = SSQ[(size_t)m * 16 + (lane & 15)];
#pragma unroll
            for (int j = 0; j < 4; ++j) {
                static_assert(HIN_BF, "the residual stream is stored as bf16");
                v[r][j] = ((const u32x2*)((const bf16_t*)hin_ + (size_t)m * DM))[lane + 64 * j];
                fw[r][j] = ((const u32x2*)(F + (size_t)m * DM))[lane + 64 * j];
            }
        }
#pragma unroll
        for (int r = 0; r < R; ++r) {
            const int m = m0 + r;
            if (m < mend) {
                float ss = sqv[r]; ss += __shfl_xor(ss, 1); ss += __shfl_xor(ss, 2); ss += __shfl_xor(ss, 4); ss += __shfl_xor(ss, 8);
                const float r1 = rsq(ss * (1.f / DM) + EPS) * coef;
                f32x4 h[4]; float s2 = 0.f;
#pragma unroll
                for (int j = 0; j < 4; ++j) {
                    f32x4 vv;
                    { const unsigned w0 = v[r][j].x, w1 = v[r][j].y; vv[0] = bf_lo(w0); vv[1] = bf_hi(w0); vv[2] = bf_lo(w1); vv[3] = bf_hi(w1); }
                    f32x4 f; f[0] = bf_lo(fw[r][j].x); f[1] = bf_hi(fw[r][j].x); f[2] = bf_lo(fw[r][j].y); f[3] = bf_hi(fw[r][j].y);
                    h[j] = vv + r1 * f * gp[j];
                    s2 += (h[j][0] * h[j][0] + h[j][1] * h[j][1]) + (h[j][2] * h[j][2] + h[j][3] * h[j][3]);
                    if (HOUT_BF) { u32x2 w; w.x = cvt_pk_bf16(h[j][0], h[j][1]); w.y = cvt_pk_bf16(h[j][2], h[j][3]); ((u32x2*)((bf16_t*)hout_ + (size_t)m * DM))[lane + 64 * j] = w; }
                    else ((f32x4*)((float*)hout_ + (size_t)m * DM))[lane + 64 * j] = h[j];
                }
                if (XN_OUT) { const float r2 = rsq(wave_sum(s2) * (1.f / DM) + EPS); if (lane == 0) RS[m] = r2; }
            }
        }
    }
}

#define XB_TMO      128
#define XB_XCNT(j)  (256  + 64 * (j))
#define XB_XSUB(j)  (1280 + 64 * (j))
#define XB_XGEN(j)  (2304 + 64 * (j))
#define XB_TOP      3328
#define XB_TOPGEN   3392
#define XCD_BAR_WORDS 3456
#define XB_RANK(j)  (3520 + 64 * (j))
#define CTL_ZERO_BYTES 16384
#define XB_SPIN_CAP (1u << 22)
__device__ __forceinline__ unsigned xb_ld(unsigned* p)              { return __hip_atomic_load(p, __ATOMIC_RELAXED, __HIP_MEMORY_SCOPE_AGENT); }
__device__ __forceinline__ unsigned xb_add(unsigned* p, unsigned v) { return __hip_atomic_fetch_add(p, v, __ATOMIC_RELAXED, __HIP_MEMORY_SCOPE_AGENT); }
__device__ __forceinline__ unsigned xb_xcc_id() { return (unsigned)__builtin_amdgcn_s_getreg((3 << 11) | 20) & 0xFu; }
#define XB_SPIN(cond, bar) do { unsigned _sp = 0; while (cond) { __builtin_amdgcn_s_sleep(1); \
    if ((++_sp & 255u) == 0u) { if (xb_ld(&(bar)[XB_TMO])) break; if (_sp > XB_SPIN_CAP) { atomicAdd(&(bar)[XB_TMO], 1u); break; } } } } while (0)
struct XcdBarrier { unsigned* bar; unsigned x; volatile LAS unsigned* st; };
__device__ __forceinline__ XcdBarrier xcd_barrier_post(unsigned* bar, volatile LAS unsigned* st) {
    XcdBarrier b; b.bar = bar; b.x = xb_xcc_id(); b.st = st;
    if (threadIdx.x == 0) (void)xb_add(&bar[XB_XCNT(b.x)], 1u);
    return b;
}
__device__ __forceinline__ void xcd_barrier_complete(unsigned* bar, unsigned x, unsigned& nloc, unsigned& nx) {
    const unsigned G = gridDim.x * gridDim.y * gridDim.z;
    unsigned sum, cnt, mine, sp = 0u;
    for (;;) {
        sum = 0u; cnt = 0u; mine = 0u;
#pragma unroll
        for (unsigned j = 0; j < 16; ++j) { const unsigned c = xb_ld(&bar[XB_XCNT(j)]); sum += c; cnt += (c > 0u) ? 1u : 0u; mine = (j == x) ? c : mine; }
        if (sum == G) break;
        __builtin_amdgcn_s_sleep(1);
        if ((++sp & 255u) == 0u) { if (xb_ld(&bar[XB_TMO])) break; if (sp > XB_SPIN_CAP) { atomicAdd(&bar[XB_TMO], 1u); break; } }
    }
    nloc = mine > 0u ? mine : 1u; nx = cnt > 0u ? cnt : 1u;
}
__device__ __forceinline__ void xcd_barrier(const XcdBarrier& b) {
    asm volatile("s_waitcnt vmcnt(0)" ::: "memory");
    __syncthreads();
    if (threadIdx.x == 0) {
        unsigned* bar = b.bar;
        __builtin_amdgcn_s_waitcnt(0);
        unsigned nloc = b.st[0], nx = b.st[1];
        if (nloc == 0u) { xcd_barrier_complete(bar, b.x, nloc, nx); b.st[0] = nloc; b.st[1] = nx; }
        const unsigned old = xb_add(&bar[XB_XSUB(b.x)], 1u);
        const unsigned gen = old / nloc;
        if (old + 1u == (gen + 1u) * nloc) {
            __builtin_amdgcn_fence(__ATOMIC_RELEASE, "agent");
            asm volatile("s_waitcnt vmcnt(0)" ::: "memory");
            const unsigned og = xb_add(&bar[XB_TOP], 1u);
            const unsigned tg = og / nx;
            if (og + 1u == (tg + 1u) * nx) xb_add(&bar[XB_TOPGEN], 1u);
            else XB_SPIN(xb_ld(&bar[XB_TOPGEN]) == tg, bar);
            __builtin_amdgcn_fence(__ATOMIC_ACQUIRE, "agent");
            xb_add(&bar[XB_XGEN(b.x)], 1u);
            asm volatile("s_waitcnt vmcnt(0)" ::: "memory");
        } else {
            XB_SPIN(xb_ld(&bar[XB_XGEN(b.x)]) == gen, bar);
            __builtin_amdgcn_fence(__ATOMIC_ACQUIRE, "agent");
            asm volatile("s_waitcnt vmcnt(0)" ::: "memory");
        }
    }
    __syncthreads();
}


#define GRID_SYNC() xcd_barrier(bar)
__global__ void __launch_bounds__(NTHREADS, 2) hymba_fwd(Params p) {
    extern __shared__ __attribute__((aligned(16))) unsigned char lds_raw[];
    LAS unsigned char* lds = (LAS unsigned char*)lds_raw;
    cg::grid_group grid = cg::this_grid();
    const int tid = threadIdx.x, lane = tid & 63, wave = __builtin_amdgcn_readfirstlane(tid >> 6);
    const int G = gridDim.x, blk = blockIdx.x;
    const int gw = blk * NWAVES + wave, ngw = G * NWAVES;
    const int gt = blk * NTHREADS + tid, ngt = G * NTHREADS;
    unsigned char* ws = p.ws;
    const float* x = p.in[0]; const float* meta = p.in[1];
    SsmP sp; sp.lre = p.in[10]; sp.lim = p.in[11]; sp.logdt = p.in[12]; sp.bre = p.in[13]; sp.bim = p.in[14]; sp.cre = p.in[15]; sp.cim = p.in[16]; sp.dskip = p.in[17]; sp.wglu = p.in[18];
    bf16_t* Wgu1 = (bf16_t*)(ws + WS_WGU1); bf16_t* Wd1 = (bf16_t*)(ws + WS_WD1); bf16_t* Wgu2 = (bf16_t*)(ws + WS_WGU2); bf16_t* Wd2 = (bf16_t*)(ws + WS_WD2);
    bf16_t* Win = (bf16_t*)(ws + WS_WIN); bf16_t* Wout = (bf16_t*)(ws + WS_WOUT); bf16_t* M1 = (bf16_t*)(ws + WS_M1); bf16_t* W2 = (bf16_t*)(ws + WS_W2);
    float* Ktab = (float*)(ws + WS_KTAB);
    bf16_t* xn1m = (bf16_t*)(ws + WS_XN1M); bf16_t* Gm = (bf16_t*)(ws + WS_GM); float* f1m = (float*)(ws + WS_F1M); bf16_t* xn2m = (bf16_t*)(ws + WS_XN2M); float* projm = (float*)(ws + WS_PROJM);
    bf16_t* XN = (bf16_t*)(ws + WS_XN); bf16_t* Fb = (bf16_t*)(ws + WS_F); float* SSQ = (float*)(ws + WS_SSQ); bf16_t* Gbuf = (bf16_t*)(ws + WS_GBUF);
    bf16_t* UG = (bf16_t*)(ws + WS_UG); bf16_t* V = (bf16_t*)(ws + WS_V); bf16_t* OS = (bf16_t*)(ws + WS_OS); float* Sb = (float*)(ws + WS_S); float* SSQS = (float*)(ws + WS_SSQS);
    float* out = p.out; bf16_t* Hb = (bf16_t*)(ws + WS_H); float* EQ = (float*)(ws + WS_EQ); float* EP = (float*)(ws + WS_EP); float* RS = (float*)(ws + WS_RS);
    volatile LAS unsigned* bst = (volatile LAS unsigned*)(lds + STAGE_BYTES);
    if (tid == 0) { bst[0] = 0u; bst[1] = 0u; }
    __syncthreads();
    XcdBarrier bar = xcd_barrier_post((unsigned*)(ws + WS_CTL), bst);
    if (tid == 0) { bst[2] = xb_add((unsigned*)(ws + WS_CTL) + XB_RANK(bar.x), 1u); }
    grid.sync();

    {
        LAS float* scr = (LAS float*)(lds + wave * 16384);
        constexpr int I_GU = (DM / 64) * (FF / 32), I_D = (FF / 64) * (DM / 32), I_IN = (DM / 64) * (512 / 32), I_OUT = (DM / 64) * (DM / 32);
        constexpr int NIT = 4 * I_GU + 2 * I_D + I_IN + I_OUT;
        for (int it = gw; it < NIT; it += ngw) {
            int r = it;
            if (r < 4 * I_GU) {
                const int which = r / I_GU; r -= which * I_GU;
                const float* W = p.in[which == 0 ? 4 : which == 1 ? 5 : which == 2 ? 26 : 27]; bf16_t* WT = which < 2 ? Wgu1 : Wgu2;
                const int nblk = FF / 32, kb = r / nblk, nb = r % nblk, n0 = nb * 32;
                const int drow = 256 * (n0 >> 7) + (n0 & 127) + ((which & 1) ? 128 : 0);
                transpose_item(W, FF, WT, DM, drow, scr, kb * 64, n0, lane, p.in[which < 2 ? 2 : 24]); continue;
            }
            r -= 4 * I_GU;
            if (r < 2 * I_D) {
                const int which = r / I_D; r -= which * I_D;
                const float* W = p.in[which == 0 ? 6 : 28]; bf16_t* WT = which == 0 ? Wd1 : Wd2;
                const int nblk = DM / 32, kb = r / nblk, nb = r % nblk;
                transpose_item(W, DM, WT, FF, nb * 32, scr, kb * 64, nb * 32, lane); continue;
            }
            r -= 2 * I_D;
            if (r < I_IN) { const int nblk = 512 / 32, kb = r / nblk, nb = r % nblk; transpose_item(p.in[9], DM, Win, DM, nb * 32, scr, kb * 64, nb * 32, lane, p.in[7]); continue; }
            r -= I_IN;
            { const int nblk = DM / 32, kb = r / nblk, nb = r % nblk; transpose_item(p.in[23], DM, Wout, DM, nb * 32, scr, kb * 64, nb * 32, lane, kb * 64 < 512 ? p.in[21] : p.in[22] - 512); }
        }
        for (int it = gw; it < 8 * 128; it += ngw) {
            const int db = it >> 7, k0 = (it & 127) * 8, d = db * 64 + lane, gi = d >> 7, dd = d & 127;
            const float* pw = p.in[19] + (size_t)gi * 128 * 128 + dd; const float* wi = p.in[9] + (size_t)k0 * DM + 512 + gi * 128;
            float a[8];
#pragma unroll
            for (int kk = 0; kk < 8; ++kk) a[kk] = 0.f;
#pragma unroll 32
            for (int c = 0; c < 128; ++c) { const float pv = pw[(size_t)c * 128];
#pragma unroll
                for (int kk = 0; kk < 8; ++kk) a[kk] += wi[(size_t)kk * DM + c] * pv; }
            const float sc = p.in[20][d]; const f32x4 gm0 = *(const f32x4*)(p.in[7] + k0), gm1 = *(const f32x4*)(p.in[7] + k0 + 4);
            u32x4 o; o.x = cvt_pk_bf16(a[0] * sc * gm0[0], a[1] * sc * gm0[1]); o.y = cvt_pk_bf16(a[2] * sc * gm0[2], a[3] * sc * gm0[3]); o.z = cvt_pk_bf16(a[4] * sc * gm1[0], a[5] * sc * gm1[1]); o.w = cvt_pk_bf16(a[6] * sc * gm1[2], a[7] * sc * gm1[3]);
            *(u32x4*)(Win + (size_t)(512 + d) * DM + k0) = o;
        }
        for (int it = gw; it < 32 * 64; it += ngw) {
            const int g = it >> 6, tau = it & 63;
            { float er, ei, qr, qi; ssm_apow(sp, g, lane, (float)tau, er, ei); ssm_q(sp, g, lane, qr, qi);
              scr[lane] = er * qr - ei * qi; scr[64 + lane] = er * qi + ei * qr; }
            asm volatile("s_waitcnt lgkmcnt(0)" ::: "memory");
            const int ho = lane >> 2, hq = lane & 3;
            float a0 = 0.f, a1 = 0.f, a2 = 0.f, a3 = 0.f;
#pragma unroll 16
            for (int n = 0; n < 64; ++n) {
                const float fr_ = scr[n], fi_ = scr[64 + n];
                const float cr = sp.cre[(size_t)(g * 16 + ho) * 64 + n], ci = sp.cim[(size_t)(g * 16 + ho) * 64 + n];
                const float wr_ = cr * fr_ - ci * fi_, wi_ = cr * fi_ + ci * fr_;
                const f32x4 br = *(const f32x4*)(sp.bre + (size_t)(g * 64 + n) * 16 + 4 * hq), bi = *(const f32x4*)(sp.bim + (size_t)(g * 64 + n) * 16 + 4 * hq);
                a0 += wr_ * br[0] - wi_ * bi[0]; a1 += wr_ * br[1] - wi_ * bi[1]; a2 += wr_ * br[2] - wi_ * bi[2]; a3 += wr_ * br[3] - wi_ * bi[3];
            }
            if (tau == 0) { const float dv = sp.dskip[g * 16 + ho]; const int j = ho - 4 * hq; if (j == 0) a0 += dv; if (j == 1) a1 += dv; if (j == 2) a2 += dv; if (j == 3) a3 += dv; }
            *(f32x4*)(Ktab + ((size_t)(g * 64 + tau) * 16 + ho) * 16 + 4 * hq) = (f32x4){a0, a1, a2, a3};
            asm volatile("s_waitcnt lgkmcnt(0)" ::: "memory");
        }
        for (int it = gt; it < 32 * 65 * 64; it += ngt) {
            const int n = it & 63, pg = it >> 6, pp = pg % 65, g = pg / 65;
            float er, ei, qr, qi; ssm_apow(sp, g, n, (float)pp, er, ei); ssm_q(sp, g, n, qr, qi);
            *(float2*)(EP + ((size_t)(g * 65 + pp) * 64 + n) * 2) = make_float2(er, ei);
            if (pp < 64) *(float2*)(EQ + ((size_t)(g * 64 + pp) * 64 + n) * 2) = make_float2(er * qr - ei * qi, er * qi + ei * qr);
        }
        {
            const int rpw = (MTOK + ngw - 1) / ngw, mbeg = gw * rpw, mend = (mbeg + rpw < MTOK) ? mbeg + rpw : MTOK;
            for (int m0 = mbeg; m0 < mend; m0 += 8) {
                f32x4 v[8][4];
#pragma unroll
                for (int r = 0; r < 8; ++r) { const int m = (m0 + r < mend) ? m0 + r : m0;
#pragma unroll
                    for (int j = 0; j < 4; ++j) v[r][j] = ((const f32x4*)(x + (size_t)m * DM))[lane + 64 * j]; }
#pragma unroll
                for (int r = 0; r < 8; ++r) { const int m = m0 + r; if (m < mend) {
                    float ss = 0.f;
                    u32x2* o = (u32x2*)(XN + (size_t)m * DM) + lane;
#pragma unroll
                    for (int j = 0; j < 4; ++j) { ss += (v[r][j][0] * v[r][j][0] + v[r][j][1] * v[r][j][1]) + (v[r][j][2] * v[r][j][2] + v[r][j][3] * v[r][j][3]);
                        u32x2 w; w.x = cvt_pk_bf16(v[r][j][0], v[r][j][1]); w.y = cvt_pk_bf16(v[r][j][2], v[r][j][3]); o[64 * j] = w; }
                    const float rr = rsq(wave_sum(ss) * (1.f / DM) + EPS); if (lane == 0) RS[m] = rr; } }
            }
        }
        if (gw < 16) rms_row_to_bf16(meta + (size_t)gw * DM, nullptr, xn1m + (size_t)gw * DM, lane);
    }
    GRID_SYNC();

    int vid = blk;
    { bool even = (G % 8) == 0;
      for (unsigned j = 0; j < 16; ++j) { const unsigned cnt = xb_ld((unsigned*)(ws + WS_CTL) + XB_XCNT(j)); if (cnt != (j < 8 ? (unsigned)(G / 8) : 0u)) even = false; }
      const unsigned rk = bst[2];
      if (even && rk < (unsigned)(G / 8) && bar.x < 8u) vid = (int)(rk * 8u + bar.x); }
    vid = __builtin_amdgcn_readfirstlane(vid);
    {
        for (int it0 = gt; it0 < 32 * 256 * 128; it0 += 4 * ngt) {
            u32x4 ov[4];
#pragma unroll
            for (int u = 0; u < 4; ++u) {
                const int it = it0 + u * ngt; u32x4 o = {0u, 0u, 0u, 0u};
                const int kc = it & 127, row = (it >> 7) & 255, g = (it >> 15) & 31;
                if (it < 32 * 256 * 128 && row < 128) {
                    const int n = row & 63, part = row >> 6, s = kc >> 1, hi0 = (kc & 1) * 8;
                    const float2 f = *(const float2*)(EQ + ((size_t)(g * 64 + (63 - s)) * 64 + n) * 2);
                    const float* br = sp.bre + (size_t)(g * 64 + n) * 16 + hi0; const float* bi = sp.bim + (size_t)(g * 64 + n) * 16 + hi0;
                    const f32x4 b0 = *(const f32x4*)br, b1 = *(const f32x4*)(br + 4), c0 = *(const f32x4*)bi, c1 = *(const f32x4*)(bi + 4);
                    f32x4 v0, v1;
                    if (part == 0) { v0 = f.x * b0 - f.y * c0; v1 = f.x * b1 - f.y * c1; } else { v0 = f.x * c0 + f.y * b0; v1 = f.x * c1 + f.y * b1; }
                    o.x = cvt_pk_bf16(v0[0], v0[1]); o.y = cvt_pk_bf16(v0[2], v0[3]); o.z = cvt_pk_bf16(v1[0], v1[1]); o.w = cvt_pk_bf16(v1[2], v1[3]);
                }
                ov[u] = o;
            }
#pragma unroll
            for (int u = 0; u < 4; ++u) { const int it = it0 + u * ngt; if (it < 32 * 256 * 128) { const int kc = it & 127, row = (it >> 7) & 255, g = it >> 15; *(u32x4*)(W2 + ((size_t)(g * 256 + row) * 1024 + kc * 8)) = ov[u]; } }
        }
        for (int it0 = gt; it0 < 32 * 1024 * 144; it0 += 4 * ngt) {
            u32x4 ov[4];
#pragma unroll
            for (int u = 0; u < 4; ++u) {
                const int it = (it0 + u * ngt < 32 * 1024 * 144) ? it0 + u * ngt : it0; u32x4 o = {0u, 0u, 0u, 0u};
                const int kc = it % 144, rg = it / 144, row = rg & 1023, g = rg >> 10, t = row >> 4, ho = row & 15;
                if (kc >= 16) {
                    const int s = (kc - 16) >> 1, hi0 = (kc & 1) * 8;
                    if (s <= t) { const float* kp = Ktab + ((size_t)(g * 64 + (t - s)) * 16 + ho) * 16 + hi0; const f32x4 k0 = *(const f32x4*)kp, k1 = *(const f32x4*)(kp + 4);
                        o.x = cvt_pk_bf16(k0[0], k0[1]); o.y = cvt_pk_bf16(k0[2], k0[3]); o.z = cvt_pk_bf16(k1[0], k1[1]); o.w = cvt_pk_bf16(k1[2], k1[3]); }
                } else {
                    const int kk = kc * 8, part = kk >> 6, n0 = kk & 63;
                    const float* ep = EP + ((size_t)(g * 65 + t + 1) * 64 + n0) * 2; const float* cr = sp.cre + (size_t)(g * 16 + ho) * 64 + n0; const float* ci = sp.cim + (size_t)(g * 16 + ho) * 64 + n0;
                    float v[8];
#pragma unroll
                    for (int j = 0; j < 8; ++j) { const float er = ep[2 * j], ei = ep[2 * j + 1]; v[j] = part == 0 ? (cr[j] * er - ci[j] * ei) : -(cr[j] * ei + ci[j] * er); }
                    o.x = cvt_pk_bf16(v[0], v[1]); o.y = cvt_pk_bf16(v[2], v[3]); o.z = cvt_pk_bf16(v[4], v[5]); o.w = cvt_pk_bf16(v[6], v[7]);
                }
                ov[u] = o;
            }
#pragma unroll
            for (int u = 0; u < 4; ++u) { const int it = it0 + u * ngt; if (it < 32 * 1024 * 144) { const int kc = it % 144, rg = it / 144, row = rg & 1023, g = rg >> 10; *(u32x4*)(M1 + ((size_t)(g * 1024 + row) * KY + kc * 8)) = ov[u]; } }
        }
        for (int tile = blk; tile < FF / 16; tile += G) {
            const int n0 = tile * 16, grow = 256 * (n0 >> 7) + (n0 & 127), fr = lane & 15, fq = lane >> 4;
            const f32x4 ag = meta_tile_split(xn1m, Wgu1 + (size_t)grow * DM, DM, DM, lane, wave, (LAS f32x4*)lds);
            const f32x4 au = meta_tile_split(xn1m, Wgu1 + (size_t)(grow + 128) * DM, DM, DM, lane, wave, (LAS f32x4*)lds);
            if (wave == 0) { u32x2 w; w.x = cvt_pk_bf16(silu_f(ag[0]) * au[0], silu_f(ag[1]) * au[1]); w.y = cvt_pk_bf16(silu_f(ag[2]) * au[2], silu_f(ag[3]) * au[3]);
                *(u32x2*)(Gm + (size_t)fr * FF + n0 + 4 * fq) = w; }
        }
        Gemm gm{XN, Wgu1, DM, DM, DM, 0, 0}; StaticOrder S; S.init(MTOK, 2 * FF, G, vid); EpiSwiGLU E{Gbuf, RS};
        gemm_phase(lds, gm, S, E);
    }
    GRID_SYNC();

    {
        for (int tile = blk; tile < DM / 16; tile += G) { const int n0 = tile * 16, fr = lane & 15, fq = lane >> 4; const f32x4 a = meta_tile_split(Gm, Wd1 + (size_t)n0 * FF, FF, FF, lane, wave, (LAS f32x4*)lds); if (wave == 0) *(f32x4*)(f1m + (size_t)fr * DM + n0 + 4 * fq) = a; }
        Gemm gm{Gbuf, Wd1, FF, FF, FF, 0, 0}; StaticOrder S; S.init(MTOK, DM, G, vid); EpiRowSsq E{Fb, SSQ};
        gemm_phase(lds, gm, S, E);
    }
    GRID_SYNC();

    {
        resid_rows<true, true, true>(XN, Fb, SSQ, 0.5f, p.in[3], Hb, RS, gw, ngw, lane);
        if (gw < 16) {
            const f32x4* hr = (const f32x4*)(meta + (size_t)gw * DM) + lane; const f32x4* fr4 = (const f32x4*)(f1m + (size_t)gw * DM) + lane;
            f32x4 v[4], f[4]; float s = 0.f;
#pragma unroll
            for (int j = 0; j < 4; ++j) { v[j] = hr[64 * j]; f[j] = fr4[64 * j]; s += (f[j][0] * f[j][0] + f[j][1] * f[j][1]) + (f[j][2] * f[j][2] + f[j][3] * f[j][3]); }
            const float r1 = 0.5f * rsq(wave_sum(s) * (1.f / DM) + EPS); float s2 = 0.f;
#pragma unroll
            for (int j = 0; j < 4; ++j) { const f32x4 gp = ((const f32x4*)p.in[3])[lane + 64 * j]; v[j] = v[j] + r1 * f[j] * gp; s2 += (v[j][0] * v[j][0] + v[j][1] * v[j][1]) + (v[j][2] * v[j][2] + v[j][3] * v[j][3]); }
            const float r2 = rsq(wave_sum(s2) * (1.f / DM) + EPS);
            u32x2* o = (u32x2*)(xn2m + (size_t)gw * DM) + lane;
#pragma unroll
            for (int j = 0; j < 4; ++j) { u32x2 w; w.x = cvt_pk_bf16(v[j][0] * r2, v[j][1] * r2); w.y = cvt_pk_bf16(v[j][2] * r2, v[j][3] * r2); o[64 * j] = w; }
        }
    }
    GRID_SYNC();

    {
        for (int tile = blk; tile < DM / 16; tile += G) { const int n0 = tile * 16, fr = lane & 15, fq = lane >> 4; const f32x4 a = meta_tile_split(xn2m, Win + (size_t)n0 * DM, DM, DM, lane, wave, (LAS f32x4*)lds); if (wave == 0) { *(f32x4*)(projm + (size_t)fr * DM + n0 + 4 * fq) = a;
            if (n0 >= 512) { u32x2 w; w.x = cvt_pk_bf16(a[0], a[1]); w.y = cvt_pk_bf16(a[2], a[3]);
                for (int b = 0; b < 8; ++b) *(u32x2*)(V + ((size_t)b * 8208 + fr) * 512 + (n0 - 512) + 4 * fq) = w; } } }
        Gemm gm{Hb, Win, DM, DM, DM, 0, 0}; StaticOrder S; S.init(MTOK, DM, G, vid); EpiProj E{UG, V, RS};
        gemm_phase(lds, gm, S, E);
    }
    GRID_SYNC();

    {
        Gemm gm{UG, W2, KY, 1024, 512, (size_t)NCHUNK * KY * 2, (size_t)256 * 1024 * 2}; OrderS S{G, vid}; EpiS E{Sb};
        gemm_phase(lds, gm, S, E);
    }
    GRID_SYNC();

    if (wave == 0) {
        for (int it = blk; it < 256; it += G) {
            const int b = it >> 5, g = it & 31, n = lane;
            float ar, ai, qr, qi, a64r, a64i; ssm_apow(sp, g, n, 1.0f, ar, ai); ssm_q(sp, g, n, qr, qi); ssm_apow(sp, g, n, 64.0f, a64r, a64i);
            const float* br = sp.bre + (size_t)(g * 64 + n) * 16; const float* bi = sp.bim + (size_t)(g * 64 + n) * 16;
            float xr = 0.f, xi = 0.f;
            for (int t = 0; t < 16; ++t) {
                const float* up = projm + (size_t)t * DM + g * 16; float sr = 0.f, si = 0.f;
#pragma unroll
                for (int h = 0; h < 16; ++h) { const float uv = up[h]; sr += br[h] * uv; si += bi[h] * uv; }
                const float bur = qr * sr - qi * si, bui = qr * si + qi * sr;
                const float nxr = ar * xr - ai * xi + bur, nxi = ar * xi + ai * xr + bui; xr = nxr; xi = nxi;
            }
            const float* sp0 = Sb + ((size_t)g * NCHUNK + b * 128) * 128 + n; bf16_t* xo = UG + ((size_t)g * NCHUNK + b * 128) * KY + n;
            for (int c0 = 0; c0 < 128; c0 += 16) {
                float svr[16], svi[16];
#pragma unroll
                for (int u = 0; u < 16; ++u) { const float* q0 = sp0 + (size_t)(c0 + u) * 128; const float* q1 = q0 + (size_t)32 * NCHUNK * 128; svr[u] = q0[0] + q1[0]; svi[u] = q0[64] + q1[64]; }
#pragma unroll
                for (int u = 0; u < 16; ++u) {
                    const unsigned pk = cvt_pk_bf16(xr, xi);
                    xo[(size_t)(c0 + u) * KY] = (bf16_t)(pk & 0xffff); xo[(size_t)(c0 + u) * KY + 64] = (bf16_t)(pk >> 16);
                    const float nxr = a64r * xr - a64i * xi + svr[u], nxi = a64r * xi + a64i * xr + svi[u]; xr = nxr; xi = nxi;
                }
            }
        }
    }
    GRID_SYNC();

    {
        Gemm gm{UG, M1, KY, KY, KY, (size_t)NCHUNK * KY * 2, (size_t)1024 * KY * 2}; OrderY S{G, vid}; EpiY E{sp.wglu, XN, SSQS};
        gemm_phase(lds, gm, S, E);

    }
    GRID_SYNC();

    {
        const int wl = 2 << (lane >> 4); const float winv = 1.0f / (float)wl;
        const int rpw = (MTOK + ngw - 1) / ngw, rbeg = gw * rpw, rend = (rbeg + rpw < MTOK) ? rbeg + rpw : MTOK;
        for (int r0 = rbeg; r0 < rend; r0 += 8) {
            const bool fast = (r0 + 7 < rend) && ((r0 & 7) == 0);
            if (fast) {
                float sq[8]; u32x4 qv[23];
#pragma unroll
                for (int t = 0; t < 8; ++t) { const int r = r0 + t;
                    sq[t] = SSQS[((size_t)((lane & 31) * 4 + ((r & 63) >> 4)) * NCHUNK + (r >> 6)) * 16 + (r & 15)]; }
                const int vr3 = r0 + 7 + 16 * (((r0 + 7) >> 13) + 1);
#pragma unroll
                for (int k = 0; k < 23; ++k) qv[k] = (k < wl + 7) ? *(const u32x4*)(V + (size_t)(vr3 - k) * 512 + 8 * lane) : (u32x4){0u, 0u, 0u, 0u};
#pragma unroll
                for (int t = 0; t < 8; ++t) { const int r = r0 + t;
                    const float irs = sqrtf(wave_sum(sq[t]) * 0.5f * (1.f / 512) + EPS);
                    if (lane == 0) RS[r] = 1.0f / irs;
                    float a[8];
#pragma unroll
                    for (int q = 0; q < 8; ++q) a[q] = 0.f;
#pragma unroll
                    for (int d = 0; d < 16; ++d) { const u32x4 q = qv[d + 7 - t]; const float msk = (d < wl) ? 1.0f : 0.0f;
                        a[0] += msk * bf_lo(q.x); a[1] += msk * bf_hi(q.x); a[2] += msk * bf_lo(q.y); a[3] += msk * bf_hi(q.y); a[4] += msk * bf_lo(q.z); a[5] += msk * bf_hi(q.z); a[6] += msk * bf_lo(q.w); a[7] += msk * bf_hi(q.w); }
                    const u32x4 c = qv[7 - t];
                    const float cur[8] = {bf_lo(c.x), bf_hi(c.x), bf_lo(c.y), bf_hi(c.y), bf_lo(c.z), bf_hi(c.z), bf_lo(c.w), bf_hi(c.w)};
                    float ss = 0.f;
#pragma unroll
                    for (int q = 0; q < 8; ++q) { a[q] = a[q] * winv - cur[q]; ss += a[q] * a[q]; }
                    const float rp = rsq(wave_sum(ss) * (1.f / 512) + EPS);
                    const float sc = rp * irs;
                    u32x4 w2; w2.x = cvt_pk_bf16(a[0] * sc, a[1] * sc); w2.y = cvt_pk_bf16(a[2] * sc, a[3] * sc); w2.z = cvt_pk_bf16(a[4] * sc, a[5] * sc); w2.w = cvt_pk_bf16(a[6] * sc, a[7] * sc);
                    *(u32x4*)(XN + (size_t)r * DM + 512 + 8 * lane) = w2; }
            } else {
                for (int tt = 0; tt < 8; ++tt) { const int r = r0 + tt; if (r >= rend) break;
        const int tl = r & 8191;
        const float irs = sqrtf(wave_sum(SSQS[((size_t)((lane & 31) * 4 + ((r & 63) >> 4)) * NCHUNK + (r >> 6)) * 16 + (r & 15)]) * 0.5f * (1.f / 512) + EPS);
        if (lane == 0) RS[r] = 1.0f / irs;
        {
            const int wlen = 2 << (lane >> 4);
            float a[8], cur[8];
#pragma unroll
            for (int j = 0; j < 8; ++j) { a[j] = 0.f; cur[j] = 0.f; }
            for (int d = 0; d < 16; ++d) {
                if (d < wlen) {
                    float v[8];
                    { const u32x4 q = *(const u32x4*)(V + (size_t)(r + 16 * ((r >> 13) + 1) - d) * 512 + 8 * lane);
                        v[0] = bf_lo(q.x); v[1] = bf_hi(q.x); v[2] = bf_lo(q.y); v[3] = bf_hi(q.y); v[4] = bf_lo(q.z); v[5] = bf_hi(q.z); v[6] = bf_lo(q.w); v[7] = bf_hi(q.w); }
#pragma unroll
                    for (int j = 0; j < 8; ++j) { a[j] += v[j]; if (d == 0) cur[j] = v[j]; }
                }
            }
            const float inv = 1.0f / (float)wlen; float s = 0.f;
#pragma unroll
            for (int j = 0; j < 8; ++j) { a[j] = a[j] * inv - cur[j]; s += a[j] * a[j]; }
            const float rp = rsq(wave_sum(s) * (1.f / 512) + EPS);
            const float sc = rp * irs;
            u32x4 w; w.x = cvt_pk_bf16(a[0] * sc, a[1] * sc); w.y = cvt_pk_bf16(a[2] * sc, a[3] * sc); w.z = cvt_pk_bf16(a[4] * sc, a[5] * sc); w.w = cvt_pk_bf16(a[6] * sc, a[7] * sc);
            *(u32x4*)(XN + (size_t)r * DM + 512 + 8 * lane) = w;
        }
                    }
            }
        }
    }
    GRID_SYNC();

    {
        Gemm gm{XN, Wout, DM, DM, DM, 0, 0}; StaticOrder S; S.init(MTOK, DM, G, vid); EpiRowSsqScaled E{Fb, SSQ, RS};
        gemm_phase(lds, gm, S, E);
    }
    GRID_SYNC();

    resid_rows<true, true, true>(Hb, Fb, SSQ, 1.0f, p.in[8], Hb, RS, gw, ngw, lane);
    GRID_SYNC();

    {
        Gemm gm{Hb, Wgu2, DM, DM, DM, 0, 0}; StaticOrder S; S.init(MTOK, 2 * FF, G, vid); EpiSwiGLU E{Gbuf, RS};
        gemm_phase(lds, gm, S, E);
    }
    GRID_SYNC();
    {
        Gemm gm{Gbuf, Wd2, FF, FF, FF, 0, 0}; StaticOrder S; S.init(MTOK, DM, G, vid); EpiRowSsq E{Fb, SSQ};
        gemm_phase(lds, gm, S, E);
    }
    GRID_SYNC();

    resid_rows<false, true, false>(Hb, Fb, SSQ, 0.5f, p.in[25], out, nullptr, gw, ngw, lane);
}

extern "C" void kernel_launch(void* const* d_in, const int* in_sizes, int n_in, void* d_out, int out_size, void* d_ws, size_t ws_size, hipStream_t stream) {
    constexpr size_t kDynLds = STAGE_BYTES + 4096;
    static int grid_blocks = 0;
    if (!grid_blocks) {
        int dev = 0, cus = 0, per_cu = 0;
        hipGetDevice(&dev);
        hipDeviceGetAttribute(&cus, hipDeviceAttributeMultiprocessorCount, dev);
        hipFuncSetAttribute((const void*)hymba_fwd, hipFuncAttributeMaxDynamicSharedMemorySize, (int)kDynLds);
        hipOccupancyMaxActiveBlocksPerMultiprocessor(&per_cu, (const void*)hymba_fwd, NTHREADS, kDynLds);
        if (per_cu < 1) { fprintf(stderr, "occupancy query returned %d\n", per_cu); per_cu = 1; }
        grid_blocks = cus;
        if (ws_size < WS_END) fprintf(stderr, "workspace too small: %zu < %zu\n", ws_size, (size_t)WS_END);
    }
    (void)hipMemsetAsync((char*)d_ws + WS_CTL, 0, CTL_ZERO_BYTES, stream);
    Params p{};
    for (int i = 0; i < 29; ++i) p.in[i] = (const float*)d_in[i];
    p.out = (float*)d_out; p.ws = (unsigned char*)d_ws;
    void* args[] = {&p};
    hipError_t e = hipLaunchCooperativeKernel((const void*)hymba_fwd, dim3(grid_blocks), dim3(NTHREADS), args, kDynLds, stream);
    if (e != hipSuccess) fprintf(stderr, "cooperative launch failed: %s (grid %d)\n", hipGetErrorString(e), grid_blocks);
}
```
